# Optimizing an MI355X kernel written in HIP

```python
import math
import jax, jax.numpy as jnp
from jax import lax
import numpy as np

D_MODEL = 1024
BATCH = 16
SEQ = 2048
DEPTH = 4
DEC_BATCH = 2
DEC_SEQ = 16384
PAST_LEN = 128

RG_WIDTH = 512
RG_BLOCKS = 8
RG_BLOCK = RG_WIDTH // RG_BLOCKS
RG_CONV = 4
RG_CONV_LEFT = 2
RG_C = 8.0
N_HEADS = 8
N_KV_HEADS = 2
HEAD_DIM = 64
Q_GROUP = N_HEADS // N_KV_HEADS
ATTN_WIDTH = N_HEADS * HEAD_DIM
KV_WIDTH = N_KV_HEADS * HEAD_DIM
WINDOW = 128
BLOCK = 128
N_BUCKETS = 32
MAX_DISTANCE = 128
D_FF = 2816
FFN_CONV = 3
FFN_CONV_LEFT = 1
MIX_WIDTH = RG_WIDTH + ATTN_WIDTH
IN_COLS = 2 * RG_WIDTH + ATTN_WIDTH + 2 * KV_WIDTH
SPLITS = (RG_WIDTH, 2 * RG_WIDTH, 2 * RG_WIDTH + ATTN_WIDTH, 2 * RG_WIDTH + ATTN_WIDTH + KV_WIDTH)
ALPHA = (2 * DEPTH) ** 0.25
BETA = (8 * DEPTH) ** -0.25
LN_EPS = 1e-5
RMS_EPS = 1e-6
NEG = -1e30

kernel_name = 'hymba_rglru_swa_deepnorm_encoder'


def layer_norm(x, g, b):
    xf = x.astype(jnp.float32)
    mu = jnp.mean(xf, axis=-1, keepdims=True)
    var = jnp.mean(jnp.square(xf - mu), axis=-1, keepdims=True)
    y = (xf - mu) * lax.rsqrt(var + LN_EPS) * g.astype(jnp.float32) + b.astype(jnp.float32)
    return y.astype(x.dtype)


def rms_norm(x, g):
    xf = x.astype(jnp.float32)
    y = xf * lax.rsqrt(jnp.mean(xf * xf, axis=-1, keepdims=True) + RMS_EPS) * g.astype(jnp.float32)
    return y.astype(x.dtype)


def depthwise_conv(x, w, b, left):
    k_width = w.shape[0]
    s = x.shape[1]
    xp = jnp.pad(x, ((0, 0), (left, k_width - 1 - left), (0, 0)))
    y = b
    for k in range(k_width):
        y = y + xp[:, k:k + s] * w[k]
    return y


def _combine(left, right):
    a_l, b_l = left
    a_r, b_r = right
    return a_l * a_r, a_r * b_l + b_r


def linear_scan(a, b, reverse):
    _, h = lax.associative_scan(_combine, (a, b), reverse=reverse, axis=1)
    return h


def rglru_bidir(xr, wa, ba, wx, bx, lam):
    bsz, s, _ = xr.shape
    xb = xr.reshape(bsz, s, RG_BLOCKS, RG_BLOCK)
    ga = jnp.einsum('bsnc,enco->ebsno', xb, wa).reshape(2, bsz, s, RG_WIDTH) + ba[:, None, None, :]
    gx = jnp.einsum('bsnc,enco->ebsno', xb, wx).reshape(2, bsz, s, RG_WIDTH) + bx[:, None, None, :]
    r = jax.nn.sigmoid(ga.astype(jnp.float32))
    i = jax.nn.sigmoid(gx.astype(jnp.float32))
    log_a = -RG_C * r * jax.nn.softplus(-lam.astype(jnp.float32))[:, None, None, :]
    a = jnp.exp(log_a)
    bterm = jnp.sqrt(-jnp.expm1(2.0 * log_a)) * (i * xr.astype(jnp.float32)[None])
    h_fwd = linear_scan(a[0], bterm[0], reverse=False)
    h_bwd = linear_scan(a[1], bterm[1], reverse=True)
    return h_fwd + h_bwd


def _band_structure():
    i = np.arange(BLOCK)[:, None]
    c = np.arange(3 * BLOCK)[None, :]
    rel = (c - BLOCK) - i
    half = N_BUCKETS // 2
    exact = half // 2
    n = np.abs(rel)
    large = exact + (np.log(np.maximum(n, 1) / exact) / np.log(MAX_DISTANCE / exact) * (half - exact)).astype(np.int32)
    large = np.minimum(large, half - 1)
    bucket = np.where(n < exact, n, large) + (rel > 0).astype(np.int32) * half
    return bucket.astype(np.int32), n <= WINDOW


def windowed_attention(q, k, v, sink, band_bias, band_mask):
    bsz, s = q.shape[0], q.shape[1]
    nb = s // BLOCK
    qb = q.reshape(bsz, nb, BLOCK, N_KV_HEADS, Q_GROUP, HEAD_DIM)

    def windows(t):
        tp = jnp.pad(t, ((0, 0), (BLOCK, BLOCK), (0, 0), (0, 0)))
        tp = tp.reshape(bsz, nb + 2, BLOCK, N_KV_HEADS, HEAD_DIM)
        return jnp.concatenate([tp[:, :-2], tp[:, 1:-1], tp[:, 2:]], axis=2)

    kw = windows(k)
    vw = windows(v)
    scale = 1.0 / math.sqrt(HEAD_DIM)
    sc = jnp.einsum('bnqhgd,bnkhd->bnhgqk', qb, kw).astype(jnp.float32) * scale
    sc = sc + band_bias.astype(jnp.float32).reshape(N_KV_HEADS, Q_GROUP, BLOCK, 3 * BLOCK)
    key_pos = np.arange(nb)[:, None] * BLOCK + np.arange(3 * BLOCK)[None, :] - BLOCK
    valid = ((key_pos >= 0) & (key_pos < s))[:, None, :] & band_mask[None]
    sc = jnp.where(valid[None, :, None, None], sc, NEG)
    sink_f = sink.astype(jnp.float32).reshape(N_KV_HEADS, Q_GROUP)[:, :, None, None]
    m = jnp.maximum(jnp.max(sc, axis=-1, keepdims=True), sink_f)
    p = jnp.exp(sc - m)
    denom = jnp.sum(p, axis=-1, keepdims=True) + jnp.exp(sink_f - m)
    p = (p / denom).astype(vw.dtype)
    o = jnp.einsum('bnhgqk,bnkhd->bnqhgd', p, vw)
    return o.reshape(bsz, s, ATTN_WIDTH).astype(q.dtype)


def hybrid_mixer(x, w_in, rg_conv_w, rg_conv_b, rg_wa, rg_ba, rg_wx, rg_bx, rg_lambda,
                 attn_sink, band_bias, band_mask, norm_rg_g, norm_attn_g, w_out):
    bsz, s, _ = x.shape
    proj = x @ w_in
    xr, yr, q, k, v = jnp.split(proj, SPLITS, axis=-1)
    xr = depthwise_conv(xr, rg_conv_w, rg_conv_b, RG_CONV_LEFT)
    h = rglru_bidir(xr, rg_wa, rg_ba, rg_wx, rg_bx, rg_lambda)
    rg_out = (h * jax.nn.gelu(yr.astype(jnp.float32))).astype(x.dtype)
    attn_out = windowed_attention(q.reshape(bsz, s, N_HEADS, HEAD_DIM),
                                  k.reshape(bsz, s, N_KV_HEADS, HEAD_DIM),
                                  v.reshape(bsz, s, N_KV_HEADS, HEAD_DIM),
                                  attn_sink, band_bias, band_mask)
    mix = jnp.concatenate([rms_norm(rg_out, norm_rg_g), rms_norm(attn_out, norm_attn_g)], axis=-1)
    return mix @ w_out


def conv_ffn(x, ffn_w_in, ffn_conv_w, ffn_conv_b, ffn_w_out):
    g, u = jnp.split(x @ ffn_w_in, 2, axis=-1)
    g = depthwise_conv(g, ffn_conv_w, ffn_conv_b, FFN_CONV_LEFT)
    return (jax.nn.gelu(g) * u) @ ffn_w_out


def run_trunk(x, w_in, rg_conv_w, rg_conv_b, rg_wa, rg_ba, rg_wx, rg_bx, rg_lambda,
              attn_sink, rel_bias, norm_rg_g, norm_attn_g, w_out, ln1_g, ln1_b,
              ffn_w_in, ffn_conv_w, ffn_conv_b, ffn_w_out, ln2_g, ln2_b):
    buckets, band_mask = _band_structure()
    band_bias = jnp.transpose(rel_bias[buckets], (2, 0, 1))
    for l in range(DEPTH):
        mix = hybrid_mixer(x, w_in[l], rg_conv_w[l], rg_conv_b[l], rg_wa[l], rg_ba[l], rg_wx[l], rg_bx[l],
                           rg_lambda[l], attn_sink[l], band_bias, band_mask, norm_rg_g[l], norm_attn_g[l], w_out[l])
        x = layer_norm(ALPHA * x + mix, ln1_g[l], ln1_b[l])
        f = conv_ffn(x, ffn_w_in[l], ffn_conv_w[l], ffn_conv_b[l], ffn_w_out[l])
        x = layer_norm(ALPHA * x + f, ln2_g[l], ln2_b[l])
    return x


def setup_inputs(seed: int = 0) -> dict:
    key = jax.random.key(seed)
    ks = jax.random.split(key, 24)
    f32 = jnp.float32
    nrm = lambda k, shape, s: jax.random.normal(k, shape, f32) * s
    x_prompt = jax.random.normal(ks[0], (BATCH, SEQ, D_MODEL), f32)
    x_sample = jax.random.normal(ks[1], (DEC_BATCH, DEC_SEQ, D_MODEL), f32)
    w_in = nrm(ks[2], (DEPTH, D_MODEL, IN_COLS), D_MODEL ** -0.5)
    w_in = w_in.at[..., SPLITS[3]:].multiply(BETA)
    rg_conv_w = nrm(ks[3], (DEPTH, RG_CONV, RG_WIDTH), RG_CONV ** -0.5)
    rg_conv_b = nrm(ks[4], (DEPTH, RG_WIDTH), 0.01)
    rg_wa = nrm(ks[5], (DEPTH, 2, RG_BLOCKS, RG_BLOCK, RG_BLOCK), RG_BLOCK ** -0.5)
    rg_ba = nrm(ks[6], (DEPTH, 2, RG_WIDTH), 0.01)
    rg_wx = nrm(ks[7], (DEPTH, 2, RG_BLOCKS, RG_BLOCK, RG_BLOCK), RG_BLOCK ** -0.5)
    rg_bx = nrm(ks[8], (DEPTH, 2, RG_WIDTH), 0.01)
    a_c = jax.random.uniform(ks[9], (DEPTH, 2, RG_WIDTH), f32, minval=0.9, maxval=0.999)
    a0 = a_c ** (1.0 / RG_C)
    rg_lambda = jnp.log(a0) - jnp.log1p(-a0)
    attn_sink = nrm(ks[10], (DEPTH, N_HEADS), 0.5)
    rel_bias = nrm(ks[11], (N_BUCKETS, N_HEADS), 0.2)
    norm_rg_g = 1.0 + nrm(ks[12], (DEPTH, RG_WIDTH), 0.02)
    norm_attn_g = 1.0 + nrm(ks[13], (DEPTH, ATTN_WIDTH), 0.02)
    w_out = nrm(ks[14], (DEPTH, MIX_WIDTH, D_MODEL), BETA * MIX_WIDTH ** -0.5)
    ln1_g = 1.0 + nrm(ks[15], (DEPTH, D_MODEL), 0.02)
    ln1_b = nrm(ks[16], (DEPTH, D_MODEL), 0.02)
    ffn_w_in = nrm(ks[17], (DEPTH, D_MODEL, 2 * D_FF), BETA * D_MODEL ** -0.5)
    ffn_conv_w = nrm(ks[18], (DEPTH, FFN_CONV, D_FF), FFN_CONV ** -0.5)
    ffn_conv_b = nrm(ks[19], (DEPTH, D_FF), 0.01)
    ffn_w_out = nrm(ks[20], (DEPTH, D_FF, D_MODEL), BETA * D_FF ** -0.5)
    ln2_g = 1.0 + nrm(ks[21], (DEPTH, D_MODEL), 0.02)
    ln2_b = nrm(ks[22], (DEPTH, D_MODEL), 0.02)
    return {'x_prompt': x_prompt, 'x_sample': x_sample, 'w_in': w_in, 'rg_conv_w': rg_conv_w,
            'rg_conv_b': rg_conv_b, 'rg_wa': rg_wa, 'rg_ba': rg_ba, 'rg_wx': rg_wx, 'rg_bx': rg_bx,
            'rg_lambda': rg_lambda, 'attn_sink': attn_sink, 'rel_bias': rel_bias, 'norm_rg_g': norm_rg_g,
            'norm_attn_g': norm_attn_g, 'w_out': w_out, 'ln1_g': ln1_g, 'ln1_b': ln1_b,
            'ffn_w_in': ffn_w_in, 'ffn_conv_w': ffn_conv_w, 'ffn_conv_b': ffn_conv_b,
            'ffn_w_out': ffn_w_out, 'ln2_g': ln2_g, 'ln2_b': ln2_b}


def reference(x_prompt, x_sample, w_in, rg_conv_w, rg_conv_b, rg_wa, rg_ba, rg_wx, rg_bx, rg_lambda,
              attn_sink, rel_bias, norm_rg_g, norm_attn_g, w_out, ln1_g, ln1_b,
              ffn_w_in, ffn_conv_w, ffn_conv_b, ffn_w_out, ln2_g, ln2_b):
    y_prompt = run_trunk(x_prompt, w_in, rg_conv_w, rg_conv_b, rg_wa, rg_ba, rg_wx, rg_bx, rg_lambda,
                         attn_sink, rel_bias, norm_rg_g, norm_attn_g, w_out, ln1_g, ln1_b,
                         ffn_w_in, ffn_conv_w, ffn_conv_b, ffn_w_out, ln2_g, ln2_b)
    y_sample = run_trunk(x_sample, w_in, rg_conv_w, rg_conv_b, rg_wa, rg_ba, rg_wx, rg_bx, rg_lambda,
                         attn_sink, rel_bias, norm_rg_g, norm_attn_g, w_out, ln1_g, ln1_b,
                         ffn_w_in, ffn_conv_w, ffn_conv_b, ffn_w_out, ln2_g, ln2_b)
    return (y_prompt, y_sample)
```

```cpp
#include <hip/hip_runtime.h>
#include <hip/hip_cooperative_groups.h>
#include <cstdio>
#include <cstdint>
namespace cg = cooperative_groups;
namespace pg8 {
#define PG8_LAS __attribute__((address_space(3)))
typedef unsigned short bf16_t;
typedef short bf16x8 __attribute__((ext_vector_type(8)));
typedef float f32x4 __attribute__((ext_vector_type(4)));
typedef unsigned u32x4 __attribute__((ext_vector_type(4)));
constexpr int BM = 256, BK = 64, HALF = 128, HTB = HALF * BK * 2  , STAGE_BYTES = 8 * HTB, NXCD = 8, WGM = 8;

__host__ __device__ __forceinline__ int lds_byte(int r, int c) { const int st = (r >> 4) * 2 + (c >> 5), rr = r & 15, cc = c & 31, ob = rr * 64 + cc * 2; return st * 1024 + (ob ^ (((ob >> 9) & 1) << 5)); }
__host__ __device__ __forceinline__ void stage_rc(int b, int& R, int& C) { const int st = b / 1024, sb = b % 1024, swz = sb ^ (((sb >> 9) & 1) << 5); R = (st >> 1) * 16 + swz / 64; C = (st & 1) * 32 + (swz % 64) / 2; }
__host__ __device__ __forceinline__ int perm32(int rho) { const int n = rho >> 4, i = rho & 15; return 8 * (i >> 2) + 4 * n + (i & 3); }

struct Unit { int pm, pn; };
struct Gemm { const bf16_t* A; const bf16_t* Bt; int M, N, K, lda; };

struct StaticOrder {
    int nM, nN, nwg, G, c;
    __host__ __device__ void init(int M, int N, int G_, int c_) { nM = M / BM; nN = N / BM; nwg = nM * nN; G = G_; c = c_; }
    __host__ __device__ bool next(int i, Unit& u) const {
        const long L = (long)i * G + c; if (L >= nwg) return false;
        int wgid = (int)L; { const int q = nwg / NXCD, r = nwg % NXCD, xcd = wgid % NXCD, off = wgid / NXCD; wgid = (xcd < r ? xcd * (q + 1) : r * (q + 1) + (xcd - r) * q) + off; }
        const int nig = WGM * nN, gid = wgid / nig, fm = gid * WGM, gsz = (nM - fm) < WGM ? (nM - fm) : WGM;
        u.pm = fm + ((wgid % nig) % gsz); u.pn = (wgid % nig) / gsz; return true;
    }
    __device__ __forceinline__ void a_ready(const Unit&) const {}
    __device__ __forceinline__ void done(const Unit&) const {}
};

__device__ __forceinline__ unsigned cvt_pk_bf16(float lo, float hi) { unsigned r; asm volatile("v_cvt_pk_bf16_f32 %0, %1, %2" : "=v"(r) : "v"(lo), "v"(hi)); return r; }
typedef float f32x2 __attribute__((ext_vector_type(2)));
__device__ __forceinline__ f32x2 gelu_pk(f32x2 v) {
    const f32x2 av = __builtin_elementwise_abs(v), d = av * 0.2316418882f + 1.0f;
    f32x2 t; t.x = __builtin_amdgcn_rcpf(d.x); t.y = __builtin_amdgcn_rcpf(d.y);
    f32x2 q = t * 0.5307027145f + (-0.7265760135f); q = q * t + 0.7107068705f; q = q * t + (-0.142248368f); q = q * t + 0.127414796f; q = q * t;
    const f32x2 s = (v * v) * (-0.72134752044f);
    f32x2 e; e.x = __builtin_amdgcn_exp2f(s.x); e.y = __builtin_amdgcn_exp2f(s.y);
    const f32x2 m = v * (q * e), r = v - m;
    f32x2 o; o.x = v.x < 0.f ? m.x : r.x; o.y = v.y < 0.f ? m.y : r.y; return o;
}

template <int ACT  > struct EpiBf16 {
    static constexpr bool PERM = true, AFTER_DRAIN = false; static_assert(ACT == 0 || ACT == 1, "EpiBf16: ACT is 0 (none) or 1 (gelu_pk)");
    bf16_t* O; int ldc; const float* bias; int split_cols; size_t split_stride; float scale0;
    __device__ __forceinline__ void operator()(const f32x4 (&acc)[2][2][4][2], const Unit& u, int wr, int wc, int fr, int fq) const {
        const int row0 = u.pm * BM + wr * 64 + fr; int colt = u.pn * BM; bf16_t* base = O;
        float sc = 1.f; if (split_cols) { const int t = colt / split_cols; base += (size_t)t * split_stride; colt -= t * split_cols; if (t == 0) sc = scale0; }
        const int col0 = colt + wc * 32 + 8 * fq, bcol0 = u.pn * BM + wc * 32 + 8 * fq;
        f32x4 bv[2][2];
#pragma unroll
        for (int bj = 0; bj < 2; ++bj)
#pragma unroll
            for (int n = 0; n < 2; ++n) bv[bj][n] = bias ? *(const f32x4*)(bias + bcol0 + bj * HALF + 4 * n) : (f32x4){0.f, 0.f, 0.f, 0.f};
#pragma unroll
        for (int ai = 0; ai < 2; ++ai)
#pragma unroll
            for (int m = 0; m < 4; ++m) { bf16_t* rowp = base + (size_t)(row0 + ai * HALF + m * 16) * ldc + col0;
#pragma unroll
                for (int bj = 0; bj < 2; ++bj) { f32x4 v0 = acc[ai][bj][m][0] + bv[bj][0], v1 = acc[ai][bj][m][1] + bv[bj][1];
                    if (ACT == 1) { f32x2 a = gelu_pk((f32x2){v0[0], v0[1]}), b = gelu_pk((f32x2){v0[2], v0[3]}), c = gelu_pk((f32x2){v1[0], v1[1]}), d = gelu_pk((f32x2){v1[2], v1[3]});
                        v0 = (f32x4){a.x, a.y, b.x, b.y}; v1 = (f32x4){c.x, c.y, d.x, d.y}; }
                    v0 = v0 * sc; v1 = v1 * sc; u32x4 w; w.x = cvt_pk_bf16(v0[0], v0[1]); w.y = cvt_pk_bf16(v0[2], v0[3]); w.z = cvt_pk_bf16(v1[0], v1[1]); w.w = cvt_pk_bf16(v1[2], v1[3]);
                    *(u32x4*)(rowp + bj * HALF) = w; } }
    }
};
template <class Epi, class Sched, bool ALIGN_EPI = false, bool SP2 = false>
__device__ __forceinline__ void gemm_phase(PG8_LAS unsigned char* lds, const Gemm g, const Sched& S, const Epi& E) {
    int tid_ = threadIdx.x; asm volatile("" : "+v"(tid_)); const int tid = tid_, wid = __builtin_amdgcn_readfirstlane(tid >> 6), lane = tid & 63, wr = wid >> 2, wc = wid & 3, fr = lane & 15, fq = lane >> 4;
    const int K = g.K, nt = K / BK;
    unsigned voffA[2], voffB[2];
#pragma unroll
    for (int i = 0; i < 2; ++i) { int R, C; stage_rc(tid * 16 + i * 8192, R, C); const int Rb = Epi::PERM ? ((R & ~31) + perm32(R & 31)) : R;
        voffA[i] = (unsigned)(R * g.lda + C) * 2u; voffB[i] = (unsigned)(Rb * K + C) * 2u; }
    const size_t kstep = (size_t)(BK * 2);
    const size_t hstep = (size_t)HALF * K * 2;
    const size_t tstep = 2 * hstep; const size_t hstepA = (size_t)HALF * g.lda * 2, tstepA = 2 * hstepA;
    const unsigned ldsw = (unsigned)wid * 1024u;
    const int aoff = lds_byte(wr * 64 + fr, fq * 8), boff = lds_byte(wc * 32 + fr, fq * 8);
#define PG8_SA(b, h) (((b) * 2 + (h)) * HTB)
#define PG8_SB(b, h) ((4 + (b) * 2 + (h)) * HTB)
#define PG8_STAGE(bufoff, gbase, voff) do { _Pragma("unroll") for (int _i = 0; _i < 2; ++_i) \
        __builtin_amdgcn_global_load_lds((const unsigned*)((const char*)(gbase) + (voff)[_i]), (PG8_LAS unsigned*)(lds + (bufoff) + ldsw + _i * 8192), 16, 0, 0); } while (0)
#define PG8_LDA(dst, b, h) do { _Pragma("unroll") for (int m = 0; m < 4; ++m) _Pragma("unroll") for (int k = 0; k < 2; ++k) dst[m][k] = *(const PG8_LAS bf16x8*)(lds + PG8_SA(b, h) + aoff + m * 2048 + k * 1024); } while (0)
#define PG8_LDB(dst, b, h) do { _Pragma("unroll") for (int n = 0; n < 2; ++n) _Pragma("unroll") for (int k = 0; k < 2; ++k) dst[n][k] = *(const PG8_LAS bf16x8*)(lds + PG8_SB(b, h) + boff + n * 2048 + k * 1024); } while (0)
#define PG8_MMA(ai, bj, At, Bt) do { __builtin_amdgcn_s_setprio(1); _Pragma("unroll") for (int m = 0; m < 4; ++m) _Pragma("unroll") for (int n = 0; n < 2; ++n) _Pragma("unroll") for (int k = 0; k < 2; ++k) \
        acc[ai][bj][m][n] = __builtin_amdgcn_mfma_f32_16x16x32_bf16(Bt[n][k], At[m][k], acc[ai][bj][m][n], 0, 0, 0); __builtin_amdgcn_s_setprio(0); } while (0)
#define PG8_WAIT_V(n) asm volatile("s_waitcnt vmcnt(" #n ")" ::: "memory")
#define PG8_WAIT_L(n) asm volatile("s_waitcnt lgkmcnt(" #n ")" ::: "memory")
#define PG8_BAR __builtin_amdgcn_s_barrier()
#define PG8_SCHED __builtin_amdgcn_sched_barrier(0)
    Unit cur, nxt; int ui = 0;
    if (!S.next(0, cur)) return;
    f32x4 acc[2][2][4][2];
#pragma unroll
    for (int a = 0; a < 2; ++a)
#pragma unroll
        for (int b = 0; b < 2; ++b)
#pragma unroll
            for (int m = 0; m < 4; ++m)
#pragma unroll
                for (int n = 0; n < 2; ++n) acc[a][b][m][n] = (f32x4){0.f, 0.f, 0.f, 0.f};
    bf16x8 At[4][2], B0[2][2], B1[2][2];
    const char* cA = (const char*)g.A + (size_t)cur.pm * tstepA; const char* cB = (const char*)g.Bt + (size_t)cur.pn * tstep;
    S.a_ready(cur);
    if constexpr (SP2) {
        PG8_STAGE(PG8_SB(0, 0), cB, voffB); PG8_STAGE(PG8_SB(0, 1), cB + hstep, voffB); PG8_STAGE(PG8_SA(0, 0), cA, voffA); PG8_STAGE(PG8_SA(0, 1), cA + hstepA, voffA);
        if (wr == 1) PG8_BAR;
        PG8_WAIT_V(2); PG8_BAR;
        PG8_STAGE(PG8_SB(1, 0), cB + kstep, voffB); PG8_STAGE(PG8_SA(1, 0), cA + kstep, voffA); PG8_STAGE(PG8_SB(1, 1), cB + hstep + kstep, voffB);
        PG8_WAIT_V(6); PG8_BAR;
    } else {
        PG8_STAGE(PG8_SB(0, 0), cB, voffB); PG8_STAGE(PG8_SA(0, 0), cA, voffA); PG8_STAGE(PG8_SB(0, 1), cB + hstep, voffB); PG8_STAGE(PG8_SA(0, 1), cA + hstepA, voffA);
        if (wr == 1) PG8_BAR;
        PG8_WAIT_V(4); PG8_BAR;
        PG8_STAGE(PG8_SB(1, 0), cB + kstep, voffB); PG8_STAGE(PG8_SA(1, 0), cA + kstep, voffA); PG8_STAGE(PG8_SB(1, 1), cB + hstep + kstep, voffB);
        PG8_WAIT_V(6); PG8_BAR;
    }
    for (;;) {
        const bool has_next = S.next(ui + 1, nxt);
        const char* nA = has_next ? (const char*)g.A + (size_t)nxt.pm * tstepA : cA; const char* nB = has_next ? (const char*)g.Bt + (size_t)nxt.pn * tstep : cB;
        for (int t = 0; t < nt; t += 2) {
            const bool last = (t == nt - 2);
            const char* a1 = cA + (size_t)(t + 1) * kstep;
            const char* a2 = last ? nA : cA + (size_t)(t + 2) * kstep; const char* b2 = last ? nB : cB + (size_t)(t + 2) * kstep;
            const char* a3 = a2 + kstep; const char* b3 = b2 + kstep;
            if (last && has_next) S.a_ready(nxt);
            if constexpr (SP2) {
            PG8_LDB(B0, 0, 0); PG8_LDB(B1, 0, 1); PG8_SCHED; PG8_LDA(At, 0, 0); PG8_STAGE(PG8_SA(1, 1), a1 + hstepA, voffA);
            PG8_WAIT_V(8); PG8_WAIT_L(0); PG8_BAR; PG8_MMA(0, 0, At, B0); PG8_MMA(0, 1, At, B1); PG8_BAR; PG8_SCHED;
            PG8_LDA(At, 0, 1); PG8_STAGE(PG8_SB(0, 0), b2, voffB); PG8_STAGE(PG8_SB(0, 1), b2 + hstep, voffB); PG8_STAGE(PG8_SA(0, 0), a2, voffA);
            PG8_WAIT_V(8); PG8_WAIT_L(0); PG8_BAR; PG8_MMA(1, 0, At, B0); PG8_MMA(1, 1, At, B1); PG8_BAR; PG8_SCHED;
            PG8_LDB(B0, 1, 0); PG8_LDB(B1, 1, 1); PG8_SCHED; PG8_LDA(At, 1, 0); PG8_STAGE(PG8_SA(0, 1), a2 + hstepA, voffA);
            PG8_WAIT_V(8); PG8_WAIT_L(0); PG8_BAR; PG8_MMA(0, 0, At, B0); PG8_MMA(0, 1, At, B1); PG8_BAR; PG8_SCHED;
            PG8_LDA(At, 1, 1); PG8_STAGE(PG8_SB(1, 0), b3, voffB); PG8_STAGE(PG8_SB(1, 1), b3 + hstep, voffB); PG8_STAGE(PG8_SA(1, 0), a3, voffA);
            PG8_WAIT_V(8); PG8_WAIT_L(0); PG8_BAR; PG8_MMA(1, 0, At, B0); PG8_MMA(1, 1, At, B1); PG8_BAR; PG8_SCHED;
            } else {
            PG8_LDB(B0, 0, 0); PG8_SCHED; PG8_LDA(At, 0, 0); PG8_STAGE(PG8_SA(1, 1), a1 + hstepA, voffA);
            PG8_WAIT_L(8); PG8_BAR; PG8_WAIT_L(0); PG8_MMA(0, 0, At, B0); PG8_BAR; PG8_SCHED;
            PG8_LDB(B1, 0, 1); PG8_STAGE(PG8_SB(0, 0), b2, voffB);
            PG8_BAR; PG8_WAIT_L(0); PG8_MMA(0, 1, At, B1); PG8_BAR;
            PG8_LDA(At, 0, 1); PG8_STAGE(PG8_SA(0, 0), a2, voffA);
            PG8_BAR; PG8_WAIT_L(0); PG8_MMA(1, 0, At, B0); PG8_BAR; PG8_SCHED;
            PG8_STAGE(PG8_SB(0, 1), b2 + hstep, voffB);
            PG8_WAIT_V(6); PG8_BAR; PG8_MMA(1, 1, At, B1); PG8_BAR;
            PG8_LDB(B0, 1, 0); PG8_SCHED; PG8_LDA(At, 1, 0); PG8_STAGE(PG8_SA(0, 1), a2 + hstepA, voffA);
            PG8_WAIT_L(8); PG8_BAR; PG8_WAIT_L(0); PG8_MMA(0, 0, At, B0); PG8_BAR; PG8_SCHED;
            PG8_LDB(B1, 1, 1); PG8_STAGE(PG8_SB(1, 0), b3, voffB);
            PG8_BAR; PG8_WAIT_L(0); PG8_MMA(0, 1, At, B1); PG8_BAR;
            PG8_LDA(At, 1, 1); PG8_STAGE(PG8_SA(1, 0), a3, voffA);
            PG8_BAR; PG8_WAIT_L(0); PG8_MMA(1, 0, At, B0); PG8_BAR; PG8_SCHED;
            PG8_STAGE(PG8_SB(1, 1), b3 + hstep, voffB);
            PG8_WAIT_V(6); PG8_BAR; PG8_MMA(1, 1, At, B1); PG8_BAR;
            }
        }
        if constexpr (ALIGN_EPI) { if (wr == 0) PG8_BAR; }
        if constexpr (!Epi::AFTER_DRAIN) { E(acc, cur, wr, wc, fr, fq); S.done(cur); }
        if (!has_next) break;
#pragma unroll
        for (int a = 0; a < 2; ++a)
#pragma unroll
            for (int b = 0; b < 2; ++b)
#pragma unroll
                for (int m = 0; m < 4; ++m)
#pragma unroll
                    for (int n = 0; n < 2; ++n) acc[a][b][m][n] = (f32x4){0.f, 0.f, 0.f, 0.f};
        cur = nxt; cA = nA; cB = nB; ++ui;
        if constexpr (ALIGN_EPI) { if (wr == 1) PG8_BAR; }
    }
    PG8_WAIT_V(0);
    if constexpr (!ALIGN_EPI) { if (wr == 0) PG8_BAR; }
    PG8_BAR;
    if constexpr (Epi::AFTER_DRAIN) { E.fused(acc, cur, wr, wc, fr, fq, lds, wid, lane); S.done(cur); }
#undef PG8_SA
#undef PG8_SB
#undef PG8_STAGE
#undef PG8_LDA
#undef PG8_LDB
#undef PG8_MMA
#undef PG8_WAIT_V
#undef PG8_WAIT_L
#undef PG8_BAR
#undef PG8_SCHED
}
}
#define LAS __attribute__((address_space(3)))
typedef unsigned short bf16;
typedef short bf16x8 __attribute__((ext_vector_type(8)));
typedef float f32x4 __attribute__((ext_vector_type(4)));
typedef unsigned v4u __attribute__((ext_vector_type(4)));
typedef unsigned v2u __attribute__((ext_vector_type(2)));

constexpr int NTOK = 65536, NPROMPT = 32768, DM = 1024, NPROJ = 1792, DFF = 2816, NGU = 5632, DEPTH = 4;
constexpr float ALPHA = 1.681792830507429f;
constexpr size_t MiB = 1u << 20;
constexpr size_t WS_C8 = 1 * MiB;
constexpr size_t WS_W = 2 * MiB;
constexpr size_t W_IN_E = (size_t)NPROJ * DM, W_OUT_E = (size_t)DM * DM, W_FI_E = (size_t)NGU * DM, W_FO_E = (size_t)DM * DFF, W_G_E = 2 * 2 * 8 * 64 * 64;
constexpr size_t W_LAYER_E = W_IN_E + W_OUT_E + W_FI_E + W_FO_E + W_G_E;
constexpr size_t WS_AGG = 92 * MiB;
constexpr size_t WS_CARRY = 100 * MiB;
constexpr size_t WS_XB = 128 * MiB;
constexpr size_t WS_PROJ = 256 * MiB;
constexpr size_t WS_GU = 256 * MiB;
constexpr size_t WS_H = 608 * MiB;
static_assert(WS_W + W_LAYER_E * 2 * DEPTH <= WS_AGG, "weights fit");
static_assert(WS_PROJ + (size_t)NTOK * NPROJ * 2 <= WS_H && WS_GU + (size_t)(NTOK / 2) * NGU * 2 <= WS_H && WS_H + (size_t)NTOK * DFF * 2 <= 1024 * MiB, "ws map");
constexpr int LDS_BYTES = 147456;

struct Params {
  const float* in[23];
  float* out;
  unsigned char* ws;
};

__device__ __forceinline__ unsigned f2bf(float f) { unsigned u = __builtin_bit_cast(unsigned, f); return (u + 0x7fffu + ((u >> 16) & 1u)) >> 16; }
__device__ __forceinline__ unsigned pk2(float lo, float hi) { return pg8::cvt_pk_bf16(lo, hi); }
__device__ __forceinline__ float bf2f(unsigned v) { return __builtin_bit_cast(float, v << 16); }
__device__ __forceinline__ float bflo(unsigned w) { return __builtin_bit_cast(float, w << 16); }
__device__ __forceinline__ float bfhi(unsigned w) { return __builtin_bit_cast(float, w & 0xffff0000u); }
__device__ __forceinline__ float fast_sigmoid(float x) { return __builtin_amdgcn_rcpf(1.0f + __builtin_amdgcn_exp2f(-1.4426950408889634f * x)); }
__device__ __forceinline__ float gelu_tanh(float x) { const float u = x * (1.5957691216057308f + 0.0713548162726f * x * x); return x * fast_sigmoid(u); }
__device__ __forceinline__ void seq_bounds(int t, int& s0, int& s1) { if (t < NPROMPT) { s0 = t & ~2047; s1 = s0 + 2048; } else { s0 = NPROMPT + ((t - NPROMPT) & ~16383); s1 = s0 + 16384; } }
__device__ __forceinline__ float wave_sum(float v) {
#pragma unroll
  for (int o = 1; o < 64; o <<= 1) v += __shfl_xor(v, o);
  return v;
}

namespace pg8 {
struct EpiProj {
  static constexpr bool PERM = true, AFTER_DRAIN = false;
  bf16_t* O; int ldc; int g_lo, g_hi;
  __device__ __forceinline__ void operator()(const f32x4 (&acc)[2][2][4][2], const Unit& u, int wr, int wc, int fr, int fq) const {
    const int row0 = u.pm * BM + wr * 64 + fr; const int col0 = u.pn * BM + wc * 32 + 8 * fq;
    const bool act = (u.pn >= g_lo && u.pn < g_hi);
#pragma unroll
    for (int ai = 0; ai < 2; ++ai)
#pragma unroll
      for (int m = 0; m < 4; ++m) { bf16_t* rowp = O + (size_t)(row0 + ai * HALF + m * 16) * ldc + col0;
#pragma unroll
        for (int bj = 0; bj < 2; ++bj) { f32x4 v0 = acc[ai][bj][m][0], v1 = acc[ai][bj][m][1];
          if (act) {
#pragma unroll
            for (int e = 0; e < 4; ++e) { v0[e] = gelu_tanh(v0[e]); v1[e] = gelu_tanh(v1[e]); } }
          u32x4 w; w.x = cvt_pk_bf16(v0[0], v0[1]); w.y = cvt_pk_bf16(v0[2], v0[3]); w.z = cvt_pk_bf16(v1[0], v1[1]); w.w = cvt_pk_bf16(v1[2], v1[3]);
          *(u32x4*)(rowp + bj * HALF) = w; } }
  }
};
struct EpiRes {
  static constexpr bool PERM = false, AFTER_DRAIN = false;
  const float* base0; const float* base1; float* out; float alpha;
  __device__ __forceinline__ void operator()(const f32x4 (&acc)[2][2][4][2], const Unit& u, int wr, int wc, int fr, int fq) const {
    const int col0 = u.pn * BM + wc * 32 + 4 * fq;
#pragma unroll
    for (int ai = 0; ai < 2; ++ai)
#pragma unroll
      for (int m = 0; m < 4; ++m) { const int row = u.pm * BM + ai * HALF + wr * 64 + m * 16 + fr; const float* b = row < NPROMPT ? base0 : base1; const size_t off = (size_t)row * DM + col0;
#pragma unroll
        for (int bj = 0; bj < 2; ++bj)
#pragma unroll
          for (int n = 0; n < 2; ++n) { const f32x4 bs = *(const f32x4*)(b + off + bj * HALF + n * 16); *(f32x4*)(out + off + bj * HALF + n * 16) = bs * alpha + acc[ai][bj][m][n]; } }
  }
};
}

__device__ __forceinline__ void p0_transpose_item(const float* W, int K, int N, bf16* WT, float* scr, int item, int lane) {
  const int nblk = N / 32, kb = item / nblk, nb = item % nblk, k0 = 64 * kb, n0 = 32 * nb;
#pragma unroll 8
  for (int i = 0; i < 32; ++i) { const int kk = 2 * i + (lane >> 5); scr[kk * 33 + (lane & 31)] = W[(size_t)(k0 + kk) * N + n0 + (lane & 31)]; }
  asm volatile("s_waitcnt vmcnt(0) lgkmcnt(0)" ::: "memory");
  const int c = lane & 7;
#pragma unroll
  for (int j = 0; j < 4; ++j) { const int n = (lane >> 3) + 8 * j; const float* s = scr + (8 * c) * 33 + n;
    v4u o; o.x = pk2(s[0 * 33], s[1 * 33]); o.y = pk2(s[2 * 33], s[3 * 33]); o.z = pk2(s[4 * 33], s[5 * 33]); o.w = pk2(s[6 * 33], s[7 * 33]);
    *(v4u*)(WT + (size_t)(n0 + n) * K + k0 + 8 * c) = o; }
  asm volatile("s_waitcnt lgkmcnt(0)" ::: "memory");
}

__device__ __forceinline__ void p0_prologue(const Params& p, unsigned char* lds, int gw, int NGW, int lane, int wave) {
  float* scr = (float*)(lds + wave * 16384);
  bf16* Wb = (bf16*)(p.ws + WS_W);
  constexpr int I_IN = (DM / 64) * (NPROJ / 32), I_OUT = (DM / 64) * (DM / 32), I_FI = (DM / 64) * (NGU / 32), I_FO = (DFF / 64) * (DM / 32), I_G = 64;
  constexpr int I_LAYER = I_IN + I_OUT + I_FI + I_FO + I_G;
  for (int it = gw; it < I_LAYER * DEPTH; it += NGW) {
    const int l = it / I_LAYER; int r = it % I_LAYER;
    bf16* wl = Wb + (size_t)l * W_LAYER_E;
    if (r < I_IN) { p0_transpose_item(p.in[2] + (size_t)l * DM * NPROJ, DM, NPROJ, wl, scr, r, lane); continue; } r -= I_IN;
    if (r < I_OUT) { p0_transpose_item(p.in[14] + (size_t)l * DM * DM, DM, DM, wl + W_IN_E, scr, r, lane); continue; } r -= I_OUT;
    if (r < I_FI) { p0_transpose_item(p.in[17] + (size_t)l * DM * NGU, DM, NGU, wl + W_IN_E + W_OUT_E, scr, r, lane); continue; } r -= I_FI;
    if (r < I_FO) { p0_transpose_item(p.in[20] + (size_t)l * DFF * DM, DFF, DM, wl + W_IN_E + W_OUT_E + W_FI_E, scr, r, lane); continue; } r -= I_FO;
    {
      const int ty = r >> 5, e = (r >> 4) & 1, n = (r >> 1) & 7, item = r & 1;
      const float* src = (ty == 0 ? p.in[5] : p.in[7]) + (size_t)((l * 2 + e) * 8 + n) * 4096;
      bf16* dst = wl + W_IN_E + W_OUT_E + W_FI_E + W_FO_E + (size_t)(((e * 2 + ty) * 8) + n) * 4096;
      p0_transpose_item(src, 64, 64, dst, scr, item, lane);
    }
  }
  bf16* XB = (bf16*)(p.ws + WS_XB);
  for (int m = gw; m < NTOK; m += NGW) {
    const float* src = (m < NPROMPT) ? p.in[0] + (size_t)m * DM : p.in[1] + (size_t)(m - NPROMPT) * DM;
    const f32x4* xr = (const f32x4*)src + lane;
    v2u* o = (v2u*)(XB + (size_t)m * DM) + lane;
#pragma unroll
    for (int j = 0; j < 4; ++j) { const f32x4 v = xr[64 * j]; v2u w; w.x = pk2(v.x, v.y); w.y = pk2(v.z, v.w); o[64 * j] = w; }
  }
  float* c8 = (float*)(p.ws + WS_C8);
  for (int i = gw * 64 + lane; i < DEPTH * 2 * 512; i += NGW * 64) c8[i] = 8.0f * log1pf(expf(-p.in[9][i]));
}

__device__ __forceinline__ void ln_rows(float* X, bf16* XB, const float* gam, const float* bet, int gw, int NGW, int lane) {
  f32x4 gv[4], bv[4];
#pragma unroll
  for (int j = 0; j < 4; ++j) { gv[j] = ((const f32x4*)gam)[lane + 64 * j]; bv[j] = ((const f32x4*)bet)[lane + 64 * j]; }
  for (int m = gw; m < NTOK; m += NGW) {
    f32x4* xr = (f32x4*)(X + (size_t)m * DM) + lane;
    f32x4 v[4]; float s = 0.f;
#pragma unroll
    for (int j = 0; j < 4; ++j) { v[j] = xr[64 * j]; s += (v[j].x + v[j].y) + (v[j].z + v[j].w); }
    const float mean = wave_sum(s) * (1.f / DM); float s2 = 0.f;
#pragma unroll
    for (int j = 0; j < 4; ++j) { v[j] = v[j] - mean; s2 += (v[j].x * v[j].x + v[j].y * v[j].y) + (v[j].z * v[j].z + v[j].w * v[j].w); }
    const float rstd = 1.f / sqrtf(wave_sum(s2) * (1.f / DM) + 1e-5f);
    v2u* o8 = (v2u*)(XB + (size_t)m * DM) + lane;
#pragma unroll
    for (int j = 0; j < 4; ++j) { const f32x4 y = v[j] * rstd * gv[j] + bv[j]; xr[64 * j] = y; v2u w; w.x = pk2(y.x, y.y); w.y = pk2(y.z, y.w); o8[64 * j] = w; }
  }
}

constexpr int XCS = 520;
template <bool FINAL, int E>
__device__ __forceinline__ void rg_dir(const Params& p, const bf16* XC, int l, int chunk, int wave, int fr, int g, int nb, f32x4 (&hs)[4]) {
  const bf16* gT = (const bf16*)(p.ws + WS_W) + (size_t)l * W_LAYER_E + W_IN_E + W_OUT_E + W_FI_E + W_FO_E;
  const float* c8t = (const float*)(p.ws + WS_C8);
  {
    const int ch = 64 * wave + 16 * nb + fr;
    f32x4 ga[4], gx[4];
#pragma unroll
    for (int mb = 0; mb < 4; ++mb) { ga[mb] = (f32x4){0.f, 0.f, 0.f, 0.f}; gx[mb] = (f32x4){0.f, 0.f, 0.f, 0.f}; }
    const bf16* wa = gT + ((size_t)((E * 2 + 0) * 8 + wave) * 64 + 16 * nb + fr) * 64 + 8 * g;
    const bf16* wx = wa + 8 * 4096;
#pragma unroll
    for (int ks = 0; ks < 2; ++ks) {
      const bf16x8 Ba = *(const bf16x8*)(wa + 32 * ks), Bx = *(const bf16x8*)(wx + 32 * ks);
#pragma unroll
      for (int mb = 0; mb < 4; ++mb) {
        const bf16x8 A = *(const bf16x8*)(XC + (16 * mb + fr) * XCS + 64 * wave + 32 * ks + 8 * g);
        ga[mb] = __builtin_amdgcn_mfma_f32_16x16x32_bf16(A, Ba, ga[mb], 0, 0, 0);
        gx[mb] = __builtin_amdgcn_mfma_f32_16x16x32_bf16(A, Bx, gx[mb], 0, 0, 0);
      }
    }
    const float ba = p.in[6][(l * 2 + E) * 512 + ch], bx = p.in[8][(l * 2 + E) * 512 + ch], c8 = c8t[(l * 2 + E) * 512 + ch];
#pragma unroll
    for (int mb = 0; mb < 4; ++mb)
#pragma unroll
      for (int j = 0; j < 4; ++j) {
        const float r = fast_sigmoid(ga[mb][j] + ba), ii = fast_sigmoid(gx[mb][j] + bx);
        const float la = -c8 * r;
        const float a = __builtin_amdgcn_exp2f(1.4426950408889634f * la);
        const float y = 2.0f * la;
        const float poly = -y * (1.0f + y * (0.5f + y * (0.16666667f + y * (0.041666668f + y * (0.008333334f + y * 0.0013888889f)))));
        const float om = (y > -0.3f) ? poly : (1.0f - a * a);
        const float xcv = bf2f(XC[(16 * mb + 4 * g + j) * XCS + ch]);
        ga[mb][j] = a; gx[mb][j] = __builtin_amdgcn_sqrtf(om) * ii * xcv;
      }
    float Hc = 0.f, Ac = 1.f;
    if (FINAL) Hc = ((const float*)(p.ws + WS_CARRY))[((size_t)chunk * 2 + E) * 512 + ch];
#pragma unroll
    for (int mbi = 0; mbi < 4; ++mbi) {
      const int mb = (E == 0) ? mbi : 3 - mbi;
      float P = 1.f, Hl = 0.f, hl[4], pl[4];
#pragma unroll
      for (int ji = 0; ji < 4; ++ji) { const int j = (E == 0) ? ji : 3 - ji; Hl = ga[mb][j] * Hl + gx[mb][j]; P *= ga[mb][j]; hl[j] = Hl; pl[j] = P; }
      float Ag[4], Bg[4];
#pragma unroll
      for (int k = 0; k < 4; ++k) { Ag[k] = __shfl(P, fr + 16 * k); Bg[k] = __shfl(Hl, fr + 16 * k); }
      float c = Hc, cin = Hc;
#pragma unroll
      for (int ki = 0; ki < 4; ++ki) { const int k = (E == 0) ? ki : 3 - ki; if (g == k) cin = c; c = Ag[k] * c + Bg[k]; }
      Hc = c;
      if (!FINAL) Ac *= (Ag[0] * Ag[1]) * (Ag[2] * Ag[3]);
      if (FINAL) {
#pragma unroll
        for (int j = 0; j < 4; ++j) { const float h = hl[j] + pl[j] * cin; if (E == 0) hs[mb][j] = h; else hs[mb][j] += h; }
      }
    }
    if (!FINAL) { if (g == 0) { float2 v; v.x = Ac; v.y = Hc; ((float2*)(p.ws + WS_AGG))[((size_t)chunk * 2 + E) * 512 + ch] = v; } }
  }
}

template <bool FINAL>
__device__ __forceinline__ void rg_unit(const Params& p, unsigned char* lds, int l, int chunk, int tid, int lane, int wave) {
  bf16* XC = (bf16*)lds;
  bf16* YR = (bf16*)(lds + 66560);
  float* SSQ = (float*)(lds + 133120);
  float* RSTD = (float*)(lds + 133120 + 2048);
  bf16* proj = (bf16*)(p.ws + WS_PROJ);
  const int t0 = chunk * 64;
  int s0, s1; seq_bounds(t0, s0, s1);
  {
    const int c0 = (tid & 63) * 8;
    float w[4][8], bb[8];
#pragma unroll
    for (int k = 0; k < 4; ++k) { const f32x4 a = *(const f32x4*)(p.in[3] + (size_t)(l * 4 + k) * 512 + c0), b = *(const f32x4*)(p.in[3] + (size_t)(l * 4 + k) * 512 + c0 + 4);
      w[k][0] = a.x; w[k][1] = a.y; w[k][2] = a.z; w[k][3] = a.w; w[k][4] = b.x; w[k][5] = b.y; w[k][6] = b.z; w[k][7] = b.w; }
    { const f32x4 a = *(const f32x4*)(p.in[4] + (size_t)l * 512 + c0), b = *(const f32x4*)(p.in[4] + (size_t)l * 512 + c0 + 4);
      bb[0] = a.x; bb[1] = a.y; bb[2] = a.z; bb[3] = a.w; bb[4] = b.x; bb[5] = b.y; bb[6] = b.z; bb[7] = b.w; }
#pragma unroll 2
    for (int j = 0; j < 8; ++j) {
      const int tt = (tid >> 6) + 8 * j, t = t0 + tt;
      float acc[8];
#pragma unroll
      for (int i = 0; i < 8; ++i) acc[i] = bb[i];
#pragma unroll
      for (int k = 0; k < 4; ++k) { const int tk = t + k - 2;
        if (tk >= s0 && tk < s1) { const v4u raw = *(const v4u*)(proj + (size_t)tk * NPROJ + c0);
          acc[0] += w[k][0] * bflo(raw.x); acc[1] += w[k][1] * bfhi(raw.x); acc[2] += w[k][2] * bflo(raw.y); acc[3] += w[k][3] * bfhi(raw.y);
          acc[4] += w[k][4] * bflo(raw.z); acc[5] += w[k][5] * bfhi(raw.z); acc[6] += w[k][6] * bflo(raw.w); acc[7] += w[k][7] * bfhi(raw.w); } }
      v4u o; o.x = pk2(acc[0], acc[1]); o.y = pk2(acc[2], acc[3]); o.z = pk2(acc[4], acc[5]); o.w = pk2(acc[6], acc[7]);
      *(v4u*)(XC + tt * XCS + c0) = o;
      if (FINAL) *(v4u*)(YR + tt * XCS + c0) = *(const v4u*)(proj + (size_t)t * NPROJ + 512 + c0);
    }
  }
  __syncthreads();
  const int fr = lane & 15, g = lane >> 4;
  float part[4][4];
#pragma unroll
  for (int mb = 0; mb < 4; ++mb)
#pragma unroll
    for (int j = 0; j < 4; ++j) part[mb][j] = 0.f;
#pragma unroll 1
  for (int nb = 0; nb < 4; ++nb) {
    f32x4 hs[4];
    rg_dir<FINAL, 0>(p, XC, l, chunk, wave, fr, g, nb, hs);
    rg_dir<FINAL, 1>(p, XC, l, chunk, wave, fr, g, nb, hs);
    if (FINAL) {
      bf16* yrb = YR + (4 * g) * XCS + 64 * wave + 16 * nb + fr; asm volatile("" : "+v"(yrb));
#pragma unroll
      for (int mb = 0; mb < 4; ++mb)
#pragma unroll
        for (int j = 0; j < 4; ++j) { const float v = hs[mb][j] * bf2f(yrb[(16 * mb + j) * XCS]); part[mb][j] += v * v; yrb[(16 * mb + j) * XCS] = (bf16)f2bf(v); }
    }
  }
  if (FINAL) {
    float* sqb = SSQ + 32 * g + wave; asm volatile("" : "+v"(sqb));
#pragma unroll
    for (int mb = 0; mb < 4; ++mb)
#pragma unroll
      for (int j = 0; j < 4; ++j) { float s = part[mb][j]; s += __shfl_xor(s, 1); s += __shfl_xor(s, 2); s += __shfl_xor(s, 4); s += __shfl_xor(s, 8);
        if (fr == 0) sqb[(16 * mb + j) * 8] = s; }
    __syncthreads();
    if (tid < 64) { float s = 0.f;
#pragma unroll
      for (int w8 = 0; w8 < 8; ++w8) s += SSQ[tid * 8 + w8];
      RSTD[tid] = 1.0f / sqrtf(s * (1.0f / 512.0f) + 1e-6f); }
    __syncthreads();
    { const int c0 = (tid & 63) * 8;
      const f32x4 g0 = *(const f32x4*)(p.in[12] + (size_t)l * 512 + c0), g1 = *(const f32x4*)(p.in[12] + (size_t)l * 512 + c0 + 4);
#pragma unroll
      for (int j = 0; j < 8; ++j) { const int tt = (tid >> 6) + 8 * j; const float r = RSTD[tt]; const v4u raw = *(const v4u*)(YR + tt * XCS + c0);
        v4u o; o.x = pk2(bflo(raw.x) * r * g0.x, bfhi(raw.x) * r * g0.y); o.y = pk2(bflo(raw.y) * r * g0.z, bfhi(raw.y) * r * g0.w);
        o.z = pk2(bflo(raw.z) * r * g1.x, bfhi(raw.z) * r * g1.y); o.w = pk2(bflo(raw.w) * r * g1.z, bfhi(raw.w) * r * g1.w);
        *(v4u*)(proj + (size_t)(t0 + tt) * NPROJ + 512 + c0) = o; } }
  }
  __syncthreads();
}

__device__ __forceinline__ void rg_carry(const Params& p, int gw, int NGW, int lane) {
  const float2* agg = (const float2*)(p.ws + WS_AGG); float* carry = (float*)(p.ws + WS_CARRY);
  for (int it = gw; it < 18 * 2 * 8; it += NGW) {
    const int s = it / 16, e = (it >> 3) & 1, cgp = it & 7, ch = cgp * 64 + lane;
    const int c0 = (s < 16) ? 32 * s : 512 + 256 * (s - 16), nc = (s < 16) ? 32 : 256;
    float h = 0.f;
#pragma unroll 8
    for (int i = 0; i < nc; ++i) { const int c = (e == 0) ? c0 + i : c0 + nc - 1 - i; const size_t idx = ((size_t)c * 2 + e) * 512 + ch;
      const float2 ab = agg[idx]; carry[idx] = h; h = ab.x * h + ab.y; }
  }
}

constexpr int KS = 72;
__device__ __forceinline__ void attn_unit(const Params& p, unsigned char* lds, int l, int unit, int tid, int lane, int wave) {
  bf16* KL = (bf16*)lds;
  bf16* VT = (bf16*)(lds + 18432);
  const float* BIAS = (const float*)(lds + 36864);
  float* SSQ = (float*)(lds + 36864 + 8320);
  float* RSTD = SSQ + 512;
  bf16* proj = (bf16*)(p.ws + WS_PROJ);
  const int q0 = unit * 64; int s0, s1; seq_bounds(q0, s0, s1);
  const int h = wave, kvh = wave >> 2, fr = lane & 15, g = lane >> 4;
  bf16* QL = (bf16*)(lds + 49152) + wave * 64 * KS + fr * KS + 8 * g; asm volatile("" : "+v"(QL));
#pragma unroll
  for (int qb = 0; qb < 4; ++qb)
#pragma unroll
    for (int ks = 0; ks < 2; ++ks) *(v4u*)(QL + (16 * qb) * KS + 32 * ks) = *(const v4u*)(proj + (size_t)(q0 + 16 * qb + fr) * NPROJ + 1024 + 64 * h + 32 * ks + 8 * g);
  float m[4], lsum[4]; f32x4 O[4][4];
  const float sink = p.in[10][l * 8 + h];
#pragma unroll
  for (int qb = 0; qb < 4; ++qb) { m[qb] = sink; lsum[qb] = (g == 0) ? 1.f : 0.f;
#pragma unroll
    for (int db = 0; db < 4; ++db) O[qb][db] = (f32x4){0.f, 0.f, 0.f, 0.f}; }
  for (int jt = 0; jt < 5; ++jt) {
    const int kt0 = q0 - 128 + 64 * jt;
    if (kt0 < s0 || kt0 >= s1) continue;
    __syncthreads();
#pragma unroll
    for (int i = 0; i < 2; ++i) { const int id = tid + 512 * i, kv = id >> 9, key = (id & 511) >> 3, part = id & 7;
      *(v4u*)(KL + (kv * 64 + key) * KS + part * 8) = *(const v4u*)(proj + (size_t)(kt0 + key) * NPROJ + 1536 + 64 * kv + 8 * part); }
#pragma unroll
    for (int i = 0; i < 2; ++i) { const int id = tid + 512 * i, kv = id >> 9, key = id & 63, part = (id >> 6) & 7;
      const v4u raw = *(const v4u*)(proj + (size_t)(kt0 + key) * NPROJ + 1664 + 64 * kv + 8 * part);
      bf16* vt = VT + (kv * 64 + 8 * part) * KS + key;
      vt[0 * KS] = (bf16)(raw.x & 0xffffu); vt[1 * KS] = (bf16)(raw.x >> 16); vt[2 * KS] = (bf16)(raw.y & 0xffffu); vt[3 * KS] = (bf16)(raw.y >> 16);
      vt[4 * KS] = (bf16)(raw.z & 0xffffu); vt[5 * KS] = (bf16)(raw.z >> 16); vt[6 * KS] = (bf16)(raw.w & 0xffffu); vt[7 * KS] = (bf16)(raw.w >> 16); }
    __syncthreads();
#pragma unroll 1
    for (int sh = 0; sh < 2; ++sh) {
    bf16x8 Kf[2][2], Vf[4];
#pragma unroll
    for (int kb = 0; kb < 2; ++kb)
#pragma unroll
      for (int ks = 0; ks < 2; ++ks) Kf[kb][ks] = *(const bf16x8*)(KL + (kvh * 64 + 32 * sh + 16 * kb + fr) * KS + 32 * ks + 8 * g);
#pragma unroll
    for (int db = 0; db < 4; ++db) { const bf16* vp = VT + (kvh * 64 + 16 * db + fr) * KS + 32 * sh + 4 * g;
      const v2u lo = *(const v2u*)vp, hi = *(const v2u*)(vp + 16); v4u t; t.x = lo.x; t.y = lo.y; t.z = hi.x; t.w = hi.y; Vf[db] = __builtin_bit_cast(bf16x8, t); }
#pragma unroll
    for (int qb = 0; qb < 4; ++qb) {
      f32x4 S[2];
      const bf16x8 Q0 = *(const bf16x8*)(QL + (16 * qb) * KS), Q1 = *(const bf16x8*)(QL + (16 * qb) * KS + 32);
#pragma unroll
      for (int kb = 0; kb < 2; ++kb) { S[kb] = (f32x4){0.f, 0.f, 0.f, 0.f};
        S[kb] = __builtin_amdgcn_mfma_f32_16x16x32_bf16(Kf[kb][0], Q0, S[kb], 0, 0, 0);
        S[kb] = __builtin_amdgcn_mfma_f32_16x16x32_bf16(Kf[kb][1], Q1, S[kb], 0, 0, 0); }
      const int qpos = q0 + 16 * qb + fr;
      float mx = m[qb];
#pragma unroll
      for (int kb = 0; kb < 2; ++kb)
#pragma unroll
        for (int j = 0; j < 4; ++j) { const int rel = (kt0 + 32 * sh + 16 * kb + 4 * g + j) - qpos; int idx = rel + 128; idx = idx < 0 ? 0 : (idx > 256 ? 256 : idx);
          float s = S[kb][j] * 0.125f + BIAS[h * 260 + idx]; if (rel < -128 || rel > 128) s = -1e30f; S[kb][j] = s; mx = fmaxf(mx, s); }
      mx = fmaxf(mx, __shfl_xor(mx, 16)); mx = fmaxf(mx, __shfl_xor(mx, 32));
      const float alpha = __builtin_amdgcn_exp2f((m[qb] - mx) * 1.4426950408889634f); m[qb] = mx;
      float ps = 0.f;
#pragma unroll
      for (int kb = 0; kb < 2; ++kb)
#pragma unroll
        for (int j = 0; j < 4; ++j) { const float pv = __builtin_amdgcn_exp2f((S[kb][j] - mx) * 1.4426950408889634f); ps += pv; S[kb][j] = pv; }
      lsum[qb] = lsum[qb] * alpha + ps;
#pragma unroll
      for (int db = 0; db < 4; ++db) O[qb][db] = O[qb][db] * alpha;
      { v4u t; t.x = pk2(S[0][0], S[0][1]); t.y = pk2(S[0][2], S[0][3]); t.z = pk2(S[1][0], S[1][1]); t.w = pk2(S[1][2], S[1][3]);
        const bf16x8 P = __builtin_bit_cast(bf16x8, t);
#pragma unroll
        for (int db = 0; db < 4; ++db) O[qb][db] = __builtin_amdgcn_mfma_f32_16x16x32_bf16(Vf[db], P, O[qb][db], 0, 0, 0); }
    }
    }
  }
#pragma unroll
  for (int qb = 0; qb < 4; ++qb) { float L = lsum[qb]; L += __shfl_xor(L, 16); L += __shfl_xor(L, 32); const float inv = 1.0f / L; float s = 0.f;
#pragma unroll
    for (int db = 0; db < 4; ++db) { O[qb][db] = O[qb][db] * inv; s += (O[qb][db][0] * O[qb][db][0] + O[qb][db][1] * O[qb][db][1]) + (O[qb][db][2] * O[qb][db][2] + O[qb][db][3] * O[qb][db][3]); }
    s += __shfl_xor(s, 16); s += __shfl_xor(s, 32);
    if (g == 0) SSQ[(16 * qb + fr) * 8 + wave] = s; }
  __syncthreads();
  if (tid < 64) { float s = 0.f;
#pragma unroll
    for (int w8 = 0; w8 < 8; ++w8) s += SSQ[tid * 8 + w8];
    RSTD[tid] = 1.0f / sqrtf(s * (1.0f / 512.0f) + 1e-6f); }
  __syncthreads();
#pragma unroll
  for (int qb = 0; qb < 4; ++qb) { const float r = RSTD[16 * qb + fr];
#pragma unroll
    for (int db = 0; db < 4; ++db) { const int ch = 64 * h + 16 * db + 4 * g; const f32x4 gv = *(const f32x4*)(p.in[13] + (size_t)l * 512 + ch);
      const f32x4 o = O[qb][db] * r * gv; v2u w; w.x = pk2(o[0], o[1]); w.y = pk2(o[2], o[3]);
      *(v2u*)(proj + (size_t)(q0 + 16 * qb + fr) * NPROJ + 1024 + ch) = w; } }
}

__device__ __forceinline__ void attn_bias_table(const Params& p, unsigned char* lds, int tid) {
  float* BIAS = (float*)(lds + 36864);
  for (int idx = tid; idx < 8 * 257; idx += 512) { const int hh = idx / 257, r = idx % 257 - 128; const int n = r < 0 ? -r : r; int b;
    if (n < 8) b = n; else { const int k = 31 - __clz((n * n) >> 6); b = 8 + k; if (b > 15) b = 15; }
    if (r > 0) b += 16;
    BIAS[hh * 260 + r + 128] = p.in[11][b * 8 + hh]; }
}

__device__ __forceinline__ void ffn_gate_rows(const Params& p, int l, int r0, int nrows, int gtid, int nthreads) {
  const bf16* gu = (const bf16*)(p.ws + WS_GU); bf16* H = (bf16*)(p.ws + WS_H);
  const float* cw = p.in[18] + (size_t)l * 3 * DFF; const float* cb = p.in[19] + (size_t)l * DFF;
  const int total = nrows * (DFF / 8);
  for (int idx = gtid; idx < total; idx += nthreads) {
    const int rr = idx / (DFF / 8), c0 = (idx % (DFF / 8)) * 8, row = r0 + rr;
    int s0, s1; seq_bounds(row, s0, s1);
    const bf16* gp = gu + (size_t)rr * NGU + c0;
    const v4u gm = *(const v4u*)gp, uu = *(const v4u*)(gp + DFF);
    v4u gl = (v4u){0u, 0u, 0u, 0u}, gr = (v4u){0u, 0u, 0u, 0u};
    if (row > s0) gl = *(const v4u*)(gp - NGU);
    if (row + 1 < s1) gr = *(const v4u*)(gp + NGU);
    float o[8];
    const unsigned gmw[4] = {gm.x, gm.y, gm.z, gm.w}, glw[4] = {gl.x, gl.y, gl.z, gl.w}, grw[4] = {gr.x, gr.y, gr.z, gr.w}, uw[4] = {uu.x, uu.y, uu.z, uu.w};
#pragma unroll
    for (int q = 0; q < 4; ++q) {
#pragma unroll
      for (int hlf = 0; hlf < 2; ++hlf) { const int c = c0 + 2 * q + hlf;
        const float a = hlf ? bfhi(glw[q]) : bflo(glw[q]), b = hlf ? bfhi(gmw[q]) : bflo(gmw[q]), d = hlf ? bfhi(grw[q]) : bflo(grw[q]), uv = hlf ? bfhi(uw[q]) : bflo(uw[q]);
        const float cv = cb[c] + cw[c] * a + cw[DFF + c] * b + cw[2 * DFF + c] * d;
        o[2 * q + hlf] = gelu_tanh(cv) * uv; } }
    v4u w; w.x = pk2(o[0], o[1]); w.y = pk2(o[2], o[3]); w.z = pk2(o[4], o[5]); w.w = pk2(o[6], o[7]);
    *(v4u*)(H + (size_t)row * DFF + c0) = w;
  }
}

__global__ void __launch_bounds__(512, 2) fwd_kernel(Params p) {
  cg::grid_group grid = cg::this_grid();
  extern __shared__ __attribute__((aligned(16))) unsigned char lds[];
  const int G = gridDim.x, bx = blockIdx.x, NGW = G * 8;
#define TIDS int tid = threadIdx.x; asm volatile("" : "+v"(tid)); const int lane = tid & 63, wave = __builtin_amdgcn_readfirstlane(tid >> 6), gw = bx * 8 + wave; (void)lane; (void)gw;
  float* X = p.out;
  bf16* XB = (bf16*)(p.ws + WS_XB);
  bf16* proj = (bf16*)(p.ws + WS_PROJ);
  bf16* GU = (bf16*)(p.ws + WS_GU);
  bf16* H = (bf16*)(p.ws + WS_H);
  PG8_LAS unsigned char* glds = (PG8_LAS unsigned char*)lds;

#ifndef ONLY
#define ONLY 0
#endif
#define PH(k) if (ONLY == 0 || ONLY == (k))
  PH(1) { TIDS p0_prologue(p, lds, gw, NGW, lane, wave); }
  grid.sync();

  for (int l = 0; l < DEPTH; ++l) {
    const bf16* wl = (const bf16*)(p.ws + WS_W) + (size_t)l * W_LAYER_E;
    const bf16* w_in_t = wl; const bf16* w_out_t = wl + W_IN_E; const bf16* w_fi_t = w_out_t + W_OUT_E; const bf16* w_fo_t = w_fi_t + W_FI_E;
    PH(2) { pg8::Gemm g{XB, w_in_t, NTOK, NPROJ, DM, DM}; pg8::StaticOrder S; S.init(NTOK, NPROJ, G, bx);
      pg8::EpiProj E{proj, NPROJ, 2, 4};
      pg8::gemm_phase<pg8::EpiProj, pg8::StaticOrder, true, true>(glds, g, S, E); }
    grid.sync();
    PH(3) { TIDS for (int u = bx; u < 1024; u += G) rg_unit<false>(p, lds, l, u, tid, lane, wave); }
    PH(4) { TIDS attn_bias_table(p, lds, tid);
    __syncthreads();
    for (int u = bx; u < 1024; u += G) attn_unit(p, lds, l, u, tid, lane, wave); }
    grid.sync();
    PH(5) { TIDS rg_carry(p, gw, NGW, lane); }
    grid.sync();
    PH(6) { TIDS for (int u = bx; u < 1024; u += G) rg_unit<true>(p, lds, l, u, tid, lane, wave); }
    grid.sync();
    PH(7) { pg8::Gemm g{proj + 512, w_out_t, NTOK, DM, DM, NPROJ}; pg8::StaticOrder S; S.init(NTOK, DM, G, bx);
      pg8::EpiRes E{l == 0 ? p.in[0] : X, l == 0 ? p.in[1] - (size_t)NPROMPT * DM : X, X, ALPHA};
      pg8::gemm_phase<pg8::EpiRes, pg8::StaticOrder, true, true>(glds, g, S, E); }
    grid.sync();
    PH(8) { TIDS ln_rows(X, XB, p.in[15] + (size_t)l * DM, p.in[16] + (size_t)l * DM, gw, NGW, lane); }
    grid.sync();
    for (int hf = 0; hf < 2; ++hf) {
      PH(9) { pg8::Gemm g{XB + (size_t)hf * (NTOK / 2) * DM, w_fi_t, NTOK / 2, NGU, DM, DM}; pg8::StaticOrder S; S.init(NTOK / 2, NGU, G, bx);
        pg8::EpiProj E{GU, NGU, 0, 0};
        pg8::gemm_phase<pg8::EpiProj, pg8::StaticOrder, true, true>(glds, g, S, E); }
      grid.sync();
      PH(10) { TIDS ffn_gate_rows(p, l, hf * (NTOK / 2), NTOK / 2, bx * 512 + tid, G * 512); }
      grid.sync();
    }
    PH(11) { pg8::Gemm g{H, w_fo_t, NTOK, DM, DFF, DFF}; pg8::StaticOrder S; S.init(NTOK, DM, G, bx);
      pg8::EpiRes E{X, X, X, ALPHA};
      pg8::gemm_phase<pg8::EpiRes, pg8::StaticOrder, true, true>(glds, g, S, E); }
    grid.sync();
    PH(12) { TIDS ln_rows(X, XB, p.in[21] + (size_t)l * DM, p.in[22] + (size_t)l * DM, gw, NGW, lane); }
    grid.sync();
  }
}

extern "C" void kernel_launch(void* const* d_in, const int* in_sizes, int n_in, void* d_out, int out_size, void* d_ws, size_t ws_size, hipStream_t stream) {
  static int grid_blocks = 0;
  if (!grid_blocks) {
    int dev = 0, cus = 0, per_cu = 0;
    (void)hipGetDevice(&dev);
    (void)hipDeviceGetAttribute(&cus, hipDeviceAttributeMultiprocessorCount, dev);
    (void)hipFuncSetAttribute((const void*)fwd_kernel, hipFuncAttributeMaxDynamicSharedMemorySize, LDS_BYTES);
    (void)hipOccupancyMaxActiveBlocksPerMultiprocessor(&per_cu, fwd_kernel, 512, LDS_BYTES);
    if (per_cu < 1) per_cu = 1;
    grid_blocks = cus * per_cu;
    if (grid_blocks > 256) grid_blocks = 256;
  }
  Params p{};
  for (int i = 0; i < 23; ++i) p.in[i] = (const float*)d_in[i];
  p.out = (float*)d_out; p.ws = (unsigned char*)d_ws;
  void* args[] = {&p};
  hipError_t e = hipLaunchCooperativeKernel((void*)fwd_kernel, dim3(grid_blocks), dim3(512), args, LDS_BYTES, stream);
  if (e != hipSuccess) fprintf(stderr, "cooperative launch failed: %s (grid %d)\n", hipGetErrorString(e), grid_blocks);
}
```

```cpp
#include <hip/hip_runtime.h>
#include <hip/hip_cooperative_groups.h>
#include <cstdio>
#include <cstdint>
namespace cg = cooperative_groups;
namespace pg8 {
#define PG8_LAS __attribute__((address_space(3)))
typedef unsigned short bf16_t;
typedef short bf16x8 __attribute__((ext_vector_type(8)));
typedef float f32x4 __attribute__((ext_vector_type(4)));
typedef unsigned u32x4 __attribute__((ext_vector_type(4)));
constexpr int BM = 256, BK = 64, HALF = 128, HTB = HALF * BK * 2  , STAGE_BYTES = 8 * HTB, NXCD = 8, WGM = 8;

__host__ __device__ __forceinline__ int lds_byte(int r, int c) { const int st = (r >> 4) * 2 + (c >> 5), rr = r & 15, cc = c & 31, ob = rr * 64 + cc * 2; return st * 1024 + (ob ^ (((ob >> 9) & 1) << 5)); }
__host__ __device__ __forceinline__ void stage_rc(int b, int& R, int& C) { const int st = b / 1024, sb = b % 1024, swz = sb ^ (((sb >> 9) & 1) << 5); R = (st >> 1) * 16 + swz / 64; C = (st & 1) * 32 + (swz % 64) / 2; }
__host__ __device__ __forceinline__ int perm32(int rho) { const int n = rho >> 4, i = rho & 15; return 8 * (i >> 2) + 4 * n + (i & 3); }

struct Unit { int pm, pn; };
struct Gemm { const bf16_t* A; const bf16_t* Bt; int M, N, K, lda, a_tile_rows; };

struct StaticOrder {
    int nM, nN, nwg, G, c;
    __host__ __device__ void init(int M, int N, int G_, int c_) { nM = M / BM; nN = N / BM; nwg = nM * nN; G = G_; c = c_; }
    __host__ __device__ bool next(int i, Unit& u) const {
        const long L = (long)i * G + c; if (L >= nwg) return false;
        int wgid = (int)L; { const int q = nwg / NXCD, r = nwg % NXCD, xcd = wgid % NXCD, off = wgid / NXCD; wgid = (xcd < r ? xcd * (q + 1) : r * (q + 1) + (xcd - r) * q) + off; }
        const int nig = WGM * nN, gid = wgid / nig, fm = gid * WGM, gsz = (nM - fm) < WGM ? (nM - fm) : WGM;
        u.pm = fm + ((wgid % nig) % gsz); u.pn = (wgid % nig) / gsz; return true;
    }
    __device__ __forceinline__ void a_ready(const Unit&) const {}
    __device__ __forceinline__ void done(const Unit&) const {}
};

__device__ __forceinline__ unsigned cvt_pk_bf16(float lo, float hi) { unsigned r; asm volatile("v_cvt_pk_bf16_f32 %0, %1, %2" : "=v"(r) : "v"(lo), "v"(hi)); return r; }
typedef float f32x2 __attribute__((ext_vector_type(2)));
__device__ __forceinline__ f32x2 gelu_pk(f32x2 v) {
    const f32x2 av = __builtin_elementwise_abs(v), d = av * 0.2316418882f + 1.0f;
    f32x2 t; t.x = __builtin_amdgcn_rcpf(d.x); t.y = __builtin_amdgcn_rcpf(d.y);
    f32x2 q = t * 0.5307027145f + (-0.7265760135f); q = q * t + 0.7107068705f; q = q * t + (-0.142248368f); q = q * t + 0.127414796f; q = q * t;
    const f32x2 s = (v * v) * (-0.72134752044f);
    f32x2 e; e.x = __builtin_amdgcn_exp2f(s.x); e.y = __builtin_amdgcn_exp2f(s.y);
    const f32x2 m = v * (q * e), r = v - m;
    f32x2 o; o.x = v.x < 0.f ? m.x : r.x; o.y = v.y < 0.f ? m.y : r.y; return o;
}

template <int ACT  > struct EpiBf16 {
    static constexpr bool PERM = true, AFTER_DRAIN = false; static_assert(ACT == 0 || ACT == 1, "EpiBf16: ACT is 0 (none) or 1 (gelu_pk)");
    bf16_t* O; int ldc; const float* bias; int split_cols; size_t split_stride; float scale0;
    __device__ __forceinline__ void operator()(const f32x4 (&acc)[2][2][4][2], const Unit& u, int wr, int wc, int fr, int fq) const {
        const int row0 = u.pm * BM + wr * 64 + fr; int colt = u.pn * BM; bf16_t* base = O;
        float sc = 1.f; if (split_cols) { const int t = colt / split_cols; base += (size_t)t * split_stride; colt -= t * split_cols; if (t == 0) sc = scale0; }
        const int col0 = colt + wc * 32 + 8 * fq, bcol0 = u.pn * BM + wc * 32 + 8 * fq;
        f32x4 bv[2][2];
#pragma unroll
        for (int bj = 0; bj < 2; ++bj)
#pragma unroll
            for (int n = 0; n < 2; ++n) bv[bj][n] = bias ? *(const f32x4*)(bias + bcol0 + bj * HALF + 4 * n) : (f32x4){0.f, 0.f, 0.f, 0.f};
#pragma unroll
        for (int ai = 0; ai < 2; ++ai)
#pragma unroll
            for (int m = 0; m < 4; ++m) { bf16_t* rowp = base + (size_t)(row0 + ai * HALF + m * 16) * ldc + col0;
#pragma unroll
                for (int bj = 0; bj < 2; ++bj) { f32x4 v0 = acc[ai][bj][m][0] + bv[bj][0], v1 = acc[ai][bj][m][1] + bv[bj][1];
                    if (ACT == 1) { f32x2 a = gelu_pk((f32x2){v0[0], v0[1]}), b = gelu_pk((f32x2){v0[2], v0[3]}), c = gelu_pk((f32x2){v1[0], v1[1]}), d = gelu_pk((f32x2){v1[2], v1[3]});
                        v0 = (f32x4){a.x, a.y, b.x, b.y}; v1 = (f32x4){c.x, c.y, d.x, d.y}; }
                    v0 = v0 * sc; v1 = v1 * sc; u32x4 w; w.x = cvt_pk_bf16(v0[0], v0[1]); w.y = cvt_pk_bf16(v0[2], v0[3]); w.z = cvt_pk_bf16(v1[0], v1[1]); w.w = cvt_pk_bf16(v1[2], v1[3]);
                    *(u32x4*)(rowp + bj * HALF) = w; } }
    }
};
template <class Epi, class Sched, bool ALIGN_EPI = false, bool SP2 = false>
__device__ __forceinline__ void gemm_phase(PG8_LAS unsigned char* lds, const Gemm g, const Sched& S, const Epi& E) {
    int tid_ = threadIdx.x; asm volatile("" : "+v"(tid_)); const int tid = tid_, wid = __builtin_amdgcn_readfirstlane(tid >> 6), lane = tid & 63, wr = wid >> 2, wc = wid & 3, fr = lane & 15, fq = lane >> 4;
    const int K = g.K, nt = K / BK;
    unsigned voffA[2], voffB[2];
#pragma unroll
    for (int i = 0; i < 2; ++i) { int R, C; stage_rc(tid * 16 + i * 8192, R, C); const int Rb = Epi::PERM ? ((R & ~31) + perm32(R & 31)) : R;
        voffA[i] = (unsigned)(R * g.lda + C) * 2u; voffB[i] = (unsigned)(Rb * K + C) * 2u; }
    const size_t kstep = (size_t)(BK * 2);
    const size_t hstep = (size_t)HALF * K * 2;
    const size_t tstep = 2 * hstep; const size_t hstepA = (size_t)HALF * g.lda * 2, tstepA = (size_t)g.a_tile_rows * g.lda * 2;
    const unsigned ldsw = (unsigned)wid * 1024u;
    const int aoff = lds_byte(wr * 64 + fr, fq * 8), boff = lds_byte(wc * 32 + fr, fq * 8);
#define PG8_SA(b, h) (((b) * 2 + (h)) * HTB)
#define PG8_SB(b, h) ((4 + (b) * 2 + (h)) * HTB)
#define PG8_STAGE(bufoff, gbase, voff) do { _Pragma("unroll") for (int _i = 0; _i < 2; ++_i) \
        __builtin_amdgcn_global_load_lds((const unsigned*)((const char*)(gbase) + (voff)[_i]), (PG8_LAS unsigned*)(lds + (bufoff) + ldsw + _i * 8192), 16, 0, 0); } while (0)
#define PG8_LDA(dst, b, h) do { _Pragma("unroll") for (int m = 0; m < 4; ++m) _Pragma("unroll") for (int k = 0; k < 2; ++k) dst[m][k] = *(const PG8_LAS bf16x8*)(lds + PG8_SA(b, h) + aoff + m * 2048 + k * 1024); } while (0)
#define PG8_LDB(dst, b, h) do { _Pragma("unroll") for (int n = 0; n < 2; ++n) _Pragma("unroll") for (int k = 0; k < 2; ++k) dst[n][k] = *(const PG8_LAS bf16x8*)(lds + PG8_SB(b, h) + boff + n * 2048 + k * 1024); } while (0)
#define PG8_MMA(ai, bj, At, Bt) do { __builtin_amdgcn_s_setprio(1); _Pragma("unroll") for (int m = 0; m < 4; ++m) _Pragma("unroll") for (int n = 0; n < 2; ++n) _Pragma("unroll") for (int k = 0; k < 2; ++k) \
        acc[ai][bj][m][n] = __builtin_amdgcn_mfma_f32_16x16x32_bf16(Bt[n][k], At[m][k], acc[ai][bj][m][n], 0, 0, 0); __builtin_amdgcn_s_setprio(0); } while (0)
#define PG8_WAIT_V(n) asm volatile("s_waitcnt vmcnt(" #n ")" ::: "memory")
#define PG8_WAIT_L(n) asm volatile("s_waitcnt lgkmcnt(" #n ")" ::: "memory")
#define PG8_BAR __builtin_amdgcn_s_barrier()
#define PG8_SCHED __builtin_amdgcn_sched_barrier(0)
    Unit cur, nxt; int ui = 0;
    if (!S.next(0, cur)) return;
    f32x4 acc[2][2][4][2];
#pragma unroll
    for (int a = 0; a < 2; ++a)
#pragma unroll
        for (int b = 0; b < 2; ++b)
#pragma unroll
            for (int m = 0; m < 4; ++m)
#pragma unroll
                for (int n = 0; n < 2; ++n) acc[a][b][m][n] = (f32x4){0.f, 0.f, 0.f, 0.f};
    bf16x8 At[4][2], B0[2][2], B1[2][2];
    const char* cA = (const char*)g.A + (size_t)cur.pm * tstepA; const char* cB = (const char*)g.Bt + (size_t)cur.pn * tstep;
    S.a_ready(cur);
    if constexpr (SP2) {
        PG8_STAGE(PG8_SB(0, 0), cB, voffB); PG8_STAGE(PG8_SB(0, 1), cB + hstep, voffB); PG8_STAGE(PG8_SA(0, 0), cA, voffA); PG8_STAGE(PG8_SA(0, 1), cA + hstepA, voffA);
        if (wr == 1) PG8_BAR;
        PG8_WAIT_V(2); PG8_BAR;
        PG8_STAGE(PG8_SB(1, 0), cB + kstep, voffB); PG8_STAGE(PG8_SA(1, 0), cA + kstep, voffA); PG8_STAGE(PG8_SB(1, 1), cB + hstep + kstep, voffB);
        PG8_WAIT_V(6); PG8_BAR;
    } else {
        PG8_STAGE(PG8_SB(0, 0), cB, voffB); PG8_STAGE(PG8_SA(0, 0), cA, voffA); PG8_STAGE(PG8_SB(0, 1), cB + hstep, voffB); PG8_STAGE(PG8_SA(0, 1), cA + hstepA, voffA);
        if (wr == 1) PG8_BAR;
        PG8_WAIT_V(4); PG8_BAR;
        PG8_STAGE(PG8_SB(1, 0), cB + kstep, voffB); PG8_STAGE(PG8_SA(1, 0), cA + kstep, voffA); PG8_STAGE(PG8_SB(1, 1), cB + hstep + kstep, voffB);
        PG8_WAIT_V(6); PG8_BAR;
    }
    for (;;) {
        const bool has_next = S.next(ui + 1, nxt);
        const char* nA = has_next ? (const char*)g.A + (size_t)nxt.pm * tstepA : cA; const char* nB = has_next ? (const char*)g.Bt + (size_t)nxt.pn * tstep : cB;
        for (int t = 0; t < nt; t += 2) {
            const bool last = (t == nt - 2);
            const char* a1 = cA + (size_t)(t + 1) * kstep;
            const char* a2 = last ? nA : cA + (size_t)(t + 2) * kstep; const char* b2 = last ? nB : cB + (size_t)(t + 2) * kstep;
            const char* a3 = a2 + kstep; const char* b3 = b2 + kstep;
            if (last && has_next) S.a_ready(nxt);
            if constexpr (SP2) {
            PG8_LDB(B0, 0, 0); PG8_LDB(B1, 0, 1); PG8_SCHED; PG8_LDA(At, 0, 0); PG8_STAGE(PG8_SA(1, 1), a1 + hstepA, voffA);
            PG8_WAIT_V(8); PG8_WAIT_L(0); PG8_BAR; PG8_MMA(0, 0, At, B0); PG8_MMA(0, 1, At, B1); PG8_BAR; PG8_SCHED;
            PG8_LDA(At, 0, 1); PG8_STAGE(PG8_SB(0, 0), b2, voffB); PG8_STAGE(PG8_SB(0, 1), b2 + hstep, voffB); PG8_STAGE(PG8_SA(0, 0), a2, voffA);
            PG8_WAIT_V(8); PG8_WAIT_L(0); PG8_BAR; PG8_MMA(1, 0, At, B0); PG8_MMA(1, 1, At, B1); PG8_BAR; PG8_SCHED;
            PG8_LDB(B0, 1, 0); PG8_LDB(B1, 1, 1); PG8_SCHED; PG8_LDA(At, 1, 0); PG8_STAGE(PG8_SA(0, 1), a2 + hstepA, voffA);
            PG8_WAIT_V(8); PG8_WAIT_L(0); PG8_BAR; PG8_MMA(0, 0, At, B0); PG8_MMA(0, 1, At, B1); PG8_BAR; PG8_SCHED;
            PG8_LDA(At, 1, 1); PG8_STAGE(PG8_SB(1, 0), b3, voffB); PG8_STAGE(PG8_SB(1, 1), b3 + hstep, voffB); PG8_STAGE(PG8_SA(1, 0), a3, voffA);
            PG8_WAIT_V(8); PG8_WAIT_L(0); PG8_BAR; PG8_MMA(1, 0, At, B0); PG8_MMA(1, 1, At, B1); PG8_BAR; PG8_SCHED;
            } else {
            PG8_LDB(B0, 0, 0); PG8_SCHED; PG8_LDA(At, 0, 0); PG8_STAGE(PG8_SA(1, 1), a1 + hstepA, voffA);
            PG8_WAIT_L(8); PG8_BAR; PG8_WAIT_L(0); PG8_MMA(0, 0, At, B0); PG8_BAR; PG8_SCHED;
            PG8_LDB(B1, 0, 1); PG8_STAGE(PG8_SB(0, 0), b2, voffB);
            PG8_BAR; PG8_WAIT_L(0); PG8_MMA(0, 1, At, B1); PG8_BAR;
            PG8_LDA(At, 0, 1); PG8_STAGE(PG8_SA(0, 0), a2, voffA);
            PG8_BAR; PG8_WAIT_L(0); PG8_MMA(1, 0, At, B0); PG8_BAR; PG8_SCHED;
            PG8_STAGE(PG8_SB(0, 1), b2 + hstep, voffB);
            PG8_WAIT_V(6); PG8_BAR; PG8_MMA(1, 1, At, B1); PG8_BAR;
            PG8_LDB(B0, 1, 0); PG8_SCHED; PG8_LDA(At, 1, 0); PG8_STAGE(PG8_SA(0, 1), a2 + hstepA, voffA);
            PG8_WAIT_L(8); PG8_BAR; PG8_WAIT_L(0); PG8_MMA(0, 0, At, B0); PG8_BAR; PG8_SCHED;
            PG8_LDB(B1, 1, 1); PG8_STAGE(PG8_SB(1, 0), b3, voffB);
            PG8_BAR; PG8_WAIT_L(0); PG8_MMA(0, 1, At, B1); PG8_BAR;
            PG8_LDA(At, 1, 1); PG8_STAGE(PG8_SA(1, 0), a3, voffA);
            PG8_BAR; PG8_WAIT_L(0); PG8_MMA(1, 0, At, B0); PG8_BAR; PG8_SCHED;
            PG8_STAGE(PG8_SB(1, 1), b3 + hstep, voffB);
            PG8_WAIT_V(6); PG8_BAR; PG8_MMA(1, 1, At, B1); PG8_BAR;
            }
        }
        if constexpr (ALIGN_EPI) { if (wr == 0) PG8_BAR; }
        if constexpr (!Epi::AFTER_DRAIN) { E(acc, cur, wr, wc, fr, fq); S.done(cur); }
        if (!has_next) break;
#pragma unroll
        for (int a = 0; a < 2; ++a)
#pragma unroll
            for (int b = 0; b < 2; ++b)
#pragma unroll
                for (int m = 0; m < 4; ++m)
#pragma unroll
                    for (int n = 0; n < 2; ++n) acc[a][b][m][n] = (f32x4){0.f, 0.f, 0.f, 0.f};
        cur = nxt; cA = nA; cB = nB; ++ui;
        if constexpr (ALIGN_EPI) { if (wr == 1) PG8_BAR; }
    }
    PG8_WAIT_V(0);
    if constexpr (!ALIGN_EPI) { if (wr == 0) PG8_BAR; }
    PG8_BAR;
    if constexpr (Epi::AFTER_DRAIN) { E.fused(acc, cur, wr, wc, fr, fq, lds, wid, lane); S.done(cur); }
#undef PG8_SA
#undef PG8_SB
#undef PG8_STAGE
#undef PG8_LDA
#undef PG8_LDB
#undef PG8_MMA
#undef PG8_WAIT_V
#undef PG8_WAIT_L
#undef PG8_BAR
#undef PG8_SCHED
}
}
#define LAS __attribute__((address_space(3)))
typedef unsigned short bf16;
typedef short bf16x8 __attribute__((ext_vector_type(8)));
typedef float f32x4 __attribute__((ext_vector_type(4)));
typedef unsigned v4u __attribute__((ext_vector_type(4)));
typedef unsigned v2u __attribute__((ext_vector_type(2)));

constexpr int NTOK = 65536, NPROMPT = 32768, DM = 1024, NPROJ = 1792, DFF = 2816, NGU = 5632, DEPTH = 4;
constexpr float ALPHA = 1.681792830507429f;
constexpr size_t MiB = 1u << 20;
constexpr size_t WS_C8 = 1 * MiB;
constexpr size_t WS_W = 2 * MiB;
constexpr size_t W_IN_E = (size_t)NPROJ * DM, W_OUT_E = (size_t)DM * DM, W_FI_E = (size_t)NGU * DM, W_FO_E = (size_t)DM * DFF, W_G_E = 2 * 2 * 8 * 64 * 64;
constexpr size_t W_LAYER_E = W_IN_E + W_OUT_E + W_FI_E + W_FO_E + W_G_E;
constexpr size_t WS_AGG = 92 * MiB;
constexpr size_t WS_CARRY = 100 * MiB;
constexpr size_t WS_XB = 128 * MiB;
constexpr size_t WS_PROJ = 256 * MiB;
constexpr size_t WS_GU = 256 * MiB;
constexpr size_t WS_H = 608 * MiB;
static_assert(WS_W + W_LAYER_E * 2 * DEPTH <= WS_AGG, "weights fit");
static_assert(WS_PROJ + (size_t)NTOK * NPROJ * 2 <= WS_H && WS_GU + (size_t)(NTOK / 2) * NGU * 2 <= WS_H && WS_H + (size_t)NTOK * DFF * 2 <= 1024 * MiB, "ws map");
constexpr int LDS_BYTES = 147456;

struct Params {
  const float* in[23];
  float* out;
  unsigned char* ws;
};

__device__ __forceinline__ unsigned f2bf(float f) { unsigned u = __builtin_bit_cast(unsigned, f); return (u + 0x7fffu + ((u >> 16) & 1u)) >> 16; }
__device__ __forceinline__ unsigned pk2(float lo, float hi) { return pg8::cvt_pk_bf16(lo, hi); }
__device__ __forceinline__ float bf2f(unsigned v) { return __builtin_bit_cast(float, v << 16); }
__device__ __forceinline__ float bflo(unsigned w) { return __builtin_bit_cast(float, w << 16); }
__device__ __forceinline__ float bfhi(unsigned w) { return __builtin_bit_cast(float, w & 0xffff0000u); }
__device__ __forceinline__ float fast_sigmoid(float x) { return __builtin_amdgcn_rcpf(1.0f + __builtin_amdgcn_exp2f(-1.4426950408889634f * x)); }
__device__ __forceinline__ float gelu_tanh(float x) { const float u = x * (1.5957691216057308f + 0.0713548162726f * x * x); return x * fast_sigmoid(u); }
__device__ __forceinline__ void seq_bounds(int t, int& s0, int& s1) { if (t < NPROMPT) { s0 = t & ~2047; s1 = s0 + 2048; } else { s0 = NPROMPT + ((t - NPROMPT) & ~16383); s1 = s0 + 16384; } }
__device__ __forceinline__ float wave_sum(float v) {
#pragma unroll
  for (int o = 1; o < 64; o <<= 1) v += __shfl_xor(v, o);
  return v;
}

namespace pg8 {
struct EpiProj {
  static constexpr bool PERM = true, AFTER_DRAIN = false;
  bf16_t* O; int ldc; int g_lo, g_hi;
  __device__ __forceinline__ void operator()(const f32x4 (&acc)[2][2][4][2], const Unit& u, int wr, int wc, int fr, int fq) const {
    const int row0 = u.pm * BM + wr * 64 + fr; const int col0 = u.pn * BM + wc * 32 + 8 * fq;
    const bool act = (u.pn >= g_lo && u.pn < g_hi);
#pragma unroll
    for (int ai = 0; ai < 2; ++ai)
#pragma unroll
      for (int m = 0; m < 4; ++m) { bf16_t* rowp = O + (size_t)(row0 + ai * HALF + m * 16) * ldc + col0;
#pragma unroll
        for (int bj = 0; bj < 2; ++bj) { f32x4 v0 = acc[ai][bj][m][0], v1 = acc[ai][bj][m][1];
          if (act) {
#pragma unroll
            for (int e = 0; e < 4; ++e) { v0[e] = gelu_tanh(v0[e]); v1[e] = gelu_tanh(v1[e]); } }
          u32x4 w; w.x = cvt_pk_bf16(v0[0], v0[1]); w.y = cvt_pk_bf16(v0[2], v0[3]); w.z = cvt_pk_bf16(v1[0], v1[1]); w.w = cvt_pk_bf16(v1[2], v1[3]);
          *(u32x4*)(rowp + bj * HALF) = w; } }
  }
};
struct EpiRes {
  static constexpr bool PERM = false, AFTER_DRAIN = false;
  const float* base0; const float* base1; float* out; float alpha;
  __device__ __forceinline__ void operator()(const f32x4 (&acc)[2][2][4][2], const Unit& u, int wr, int wc, int fr, int fq) const {
    const int col0 = u.pn * BM + wc * 32 + 4 * fq;
#pragma unroll
    for (int ai = 0; ai < 2; ++ai)
#pragma unroll
      for (int m = 0; m < 4; ++m) { const int row = u.pm * BM + ai * HALF + wr * 64 + m * 16 + fr; const float* b = row < NPROMPT ? base0 : base1; const size_t off = (size_t)row * DM + col0;
#pragma unroll
        for (int bj = 0; bj < 2; ++bj)
#pragma unroll
          for (int n = 0; n < 2; ++n) { const f32x4 bs = *(const f32x4*)(b + off + bj * HALF + n * 16); *(f32x4*)(out + off + bj * HALF + n * 16) = bs * alpha + acc[ai][bj][m][n]; } }
  }
};
__device__ __forceinline__ float dpp_ror1(float x) { return __builtin_bit_cast(float, __builtin_amdgcn_update_dpp(0, __builtin_bit_cast(int, x), 0x121, 0xf, 0xf, false)); }
__device__ __forceinline__ float dpp_rol1(float x) { return __builtin_bit_cast(float, __builtin_amdgcn_update_dpp(0, __builtin_bit_cast(int, x), 0x12F, 0xf, 0xf, false)); }
struct EpiFfn {
  static constexpr bool PERM = true, AFTER_DRAIN = false;
  bf16_t* Hout; const float* cw; const float* cb; PG8_LAS float* xch;
  __device__ __forceinline__ void operator()(const f32x4 (&acc)[2][2][4][2], const Unit& u, int wr, int wc, int fr, int fq) const {
    const int chl = wc * 32 + 8 * fq, c0 = u.pn * 128 + chl;
#pragma unroll
    for (int ai = 0; ai < 2; ++ai) { const int sl = 2 * ai + wr;
      if (fr == 0) { *(PG8_LAS f32x4*)(xch + (sl * 2 + 0) * 128 + chl) = acc[ai][0][0][0]; *(PG8_LAS f32x4*)(xch + (sl * 2 + 0) * 128 + chl + 4) = acc[ai][0][0][1]; }
      if (fr == 15) { *(PG8_LAS f32x4*)(xch + (sl * 2 + 1) * 128 + chl) = acc[ai][0][3][0]; *(PG8_LAS f32x4*)(xch + (sl * 2 + 1) * 128 + chl + 4) = acc[ai][0][3][1]; } }
    f32x4 w0[2], w1[2], w2[2], bb[2];
#pragma unroll
    for (int n = 0; n < 2; ++n) { w0[n] = *(const f32x4*)(cw + c0 + 4 * n); w1[n] = *(const f32x4*)(cw + DFF + c0 + 4 * n); w2[n] = *(const f32x4*)(cw + 2 * DFF + c0 + 4 * n); bb[n] = *(const f32x4*)(cb + c0 + 4 * n); }
    asm volatile("s_waitcnt lgkmcnt(0)" ::: "memory"); __builtin_amdgcn_s_barrier(); asm volatile("" ::: "memory");
    const int tok0 = 254 * u.pm - 1;
#pragma unroll
    for (int ai = 0; ai < 2; ++ai) { const int sl = 2 * ai + wr;
#pragma unroll
      for (int m = 0; m < 4; ++m) {
        const int rho = ai * HALF + wr * 64 + m * 16 + fr, tok = tok0 + rho;
        int s0, s1; seq_bounds(tok, s0, s1);
        const bool is_start = (tok == s0), is_end = (tok == s1 - 1);
        u32x4 w;
#pragma unroll
        for (int n = 0; n < 2; ++n) {
          const f32x4 gm = acc[ai][0][m][n]; f32x4 gl, gr;
          f32x4 el, er;
          if (m == 0) { const int sp = sl > 0 ? sl - 1 : 0; el = *(const PG8_LAS f32x4*)(xch + (sp * 2 + 1) * 128 + chl + 4 * n); }
          if (m == 3) { const int sn = sl < 3 ? sl + 1 : 3; er = *(const PG8_LAS f32x4*)(xch + (sn * 2 + 0) * 128 + chl + 4 * n); }
#pragma unroll
          for (int e = 0; e < 4; ++e) {
            const float a = dpp_ror1(gm[e]), b = dpp_rol1(gm[e]);
            float al, bl;
            if (m == 0) al = el[e]; else al = dpp_ror1(acc[ai][0][m > 0 ? m - 1 : 0][n][e]);
            if (m == 3) bl = er[e]; else bl = dpp_rol1(acc[ai][0][m < 3 ? m + 1 : 3][n][e]);
            gl[e] = (fr == 0) ? al : a; gr[e] = (fr == 15) ? bl : b;
            if (is_start) gl[e] = 0.f;
            if (is_end) gr[e] = 0.f;
          }
          const f32x4 gc = bb[n] + w0[n] * gl + w1[n] * gm + w2[n] * gr; const f32x4 uu = acc[ai][1][m][n];
          const float h0 = gelu_tanh(gc[0]) * uu[0], h1 = gelu_tanh(gc[1]) * uu[1], h2 = gelu_tanh(gc[2]) * uu[2], h3 = gelu_tanh(gc[3]) * uu[3];
          if (n == 0) { w.x = cvt_pk_bf16(h0, h1); w.y = cvt_pk_bf16(h2, h3); } else { w.z = cvt_pk_bf16(h0, h1); w.w = cvt_pk_bf16(h2, h3); }
        }
        if (rho >= 1 && rho <= 254 && tok < NTOK) *(u32x4*)(Hout + (size_t)tok * DFF + c0) = w;
      } }
    asm volatile("s_waitcnt lgkmcnt(0)" ::: "memory"); __builtin_amdgcn_s_barrier(); asm volatile("" ::: "memory");
  }
};
}

template <bool FFNPERM = false>
__device__ __forceinline__ void p0_transpose_item(const float* W, int K, int N, bf16* WT, float* scr, int item, int lane) {
  const int nblk = N / 32, kb = item / nblk, nb = item % nblk, k0 = 64 * kb, n0 = 32 * nb;
  int d0 = n0; if (FFNPERM) { const int c = n0 < DFF ? n0 : n0 - DFF; d0 = 256 * (c >> 7) + (n0 < DFF ? 0 : 128) + (c & 127); }
#pragma unroll 8
  for (int i = 0; i < 32; ++i) { const int kk = 2 * i + (lane >> 5); scr[kk * 33 + (lane & 31)] = W[(size_t)(k0 + kk) * N + n0 + (lane & 31)]; }
  asm volatile("s_waitcnt vmcnt(0) lgkmcnt(0)" ::: "memory");
  const int c = lane & 7;
#pragma unroll
  for (int j = 0; j < 4; ++j) { const int n = (lane >> 3) + 8 * j; const float* s = scr + (8 * c) * 33 + n;
    v4u o; o.x = pk2(s[0 * 33], s[1 * 33]); o.y = pk2(s[2 * 33], s[3 * 33]); o.z = pk2(s[4 * 33], s[5 * 33]); o.w = pk2(s[6 * 33], s[7 * 33]);
    *(v4u*)(WT + (size_t)(d0 + n) * K + k0 + 8 * c) = o; }
  asm volatile("s_waitcnt lgkmcnt(0)" ::: "memory");
}

__device__ __forceinline__ void p0_prologue(const Params& p, unsigned char* lds, int gw, int NGW, int lane, int wave) {
  float* scr = (float*)(lds + wave * 16384);
  bf16* Wb = (bf16*)(p.ws + WS_W);
  constexpr int I_IN = (DM / 64) * (NPROJ / 32), I_OUT = (DM / 64) * (DM / 32), I_FI = (DM / 64) * (NGU / 32), I_FO = (DFF / 64) * (DM / 32), I_G = 64;
  constexpr int I_LAYER = I_IN + I_OUT + I_FI + I_FO + I_G;
  for (int it = gw; it < I_LAYER * DEPTH; it += NGW) {
    const int l = it / I_LAYER; int r = it % I_LAYER;
    bf16* wl = Wb + (size_t)l * W_LAYER_E;
    if (r < I_IN) { p0_transpose_item(p.in[2] + (size_t)l * DM * NPROJ, DM, NPROJ, wl, scr, r, lane); continue; } r -= I_IN;
    if (r < I_OUT) { p0_transpose_item(p.in[14] + (size_t)l * DM * DM, DM, DM, wl + W_IN_E, scr, r, lane); continue; } r -= I_OUT;
    if (r < I_FI) { p0_transpose_item<true>(p.in[17] + (size_t)l * DM * NGU, DM, NGU, wl + W_IN_E + W_OUT_E, scr, r, lane); continue; } r -= I_FI;
    if (r < I_FO) { p0_transpose_item(p.in[20] + (size_t)l * DFF * DM, DFF, DM, wl + W_IN_E + W_OUT_E + W_FI_E, scr, r, lane); continue; } r -= I_FO;
    {
      const int ty = r >> 5, e = (r >> 4) & 1, n = (r >> 1) & 7, item = r & 1;
      const float* src = (ty == 0 ? p.in[5] : p.in[7]) + (size_t)((l * 2 + e) * 8 + n) * 4096;
      bf16* dst = wl + W_IN_E + W_OUT_E + W_FI_E + W_FO_E + (size_t)(((e * 2 + ty) * 8) + n) * 4096;
      p0_transpose_item(src, 64, 64, dst, scr, item, lane);
    }
  }
  bf16* XB = (bf16*)(p.ws + WS_XB);
  for (int m = gw; m < NTOK; m += NGW) {
    const float* src = (m < NPROMPT) ? p.in[0] + (size_t)m * DM : p.in[1] + (size_t)(m - NPROMPT) * DM;
    const f32x4* xr = (const f32x4*)src + lane;
    v2u* o = (v2u*)(XB + (size_t)m * DM) + lane;
#pragma unroll
    for (int j = 0; j < 4; ++j) { const f32x4 v = xr[64 * j]; v2u w; w.x = pk2(v.x, v.y); w.y = pk2(v.z, v.w); o[64 * j] = w; }
  }
  float* c8 = (float*)(p.ws + WS_C8);
  for (int i = gw * 64 + lane; i < DEPTH * 2 * 512; i += NGW * 64) c8[i] = 8.0f * log1pf(expf(-p.in[9][i]));
}

__device__ __forceinline__ void ln_rows(float* X, bf16* XB, const float* gam, const float* bet, int gw, int NGW, int lane) {
  f32x4 gv[4], bv[4];
#pragma unroll
  for (int j = 0; j < 4; ++j) { gv[j] = ((const f32x4*)gam)[lane + 64 * j]; bv[j] = ((const f32x4*)bet)[lane + 64 * j]; }
  for (int m = gw; m < NTOK; m += NGW) {
    f32x4* xr = (f32x4*)(X + (size_t)m * DM) + lane;
    f32x4 v[4]; float s = 0.f;
#pragma unroll
    for (int j = 0; j < 4; ++j) { v[j] = xr[64 * j]; s += (v[j].x + v[j].y) + (v[j].z + v[j].w); }
    const float mean = wave_sum(s) * (1.f / DM); float s2 = 0.f;
#pragma unroll
    for (int j = 0; j < 4; ++j) { v[j] = v[j] - mean; s2 += (v[j].x * v[j].x + v[j].y * v[j].y) + (v[j].z * v[j].z + v[j].w * v[j].w); }
    const float rstd = 1.f / sqrtf(wave_sum(s2) * (1.f / DM) + 1e-5f);
    v2u* o8 = (v2u*)(XB + (size_t)m * DM) + lane;
#pragma unroll
    for (int j = 0; j < 4; ++j) { const f32x4 y = v[j] * rstd * gv[j] + bv[j]; xr[64 * j] = y; v2u w; w.x = pk2(y.x, y.y); w.y = pk2(y.z, y.w); o8[64 * j] = w; }
  }
}

constexpr int XCS = 520;
template <bool FINAL, int E>
__device__ __forceinline__ void rg_dir(const Params& p, const bf16* XC, int l, int chunk, int wave, int fr, int g, int nb, f32x4 (&hs)[4]) {
  const bf16* gT = (const bf16*)(p.ws + WS_W) + (size_t)l * W_LAYER_E + W_IN_E + W_OUT_E + W_FI_E + W_FO_E;
  const float* c8t = (const float*)(p.ws + WS_C8);
  {
    const int ch = 64 * wave + 16 * nb + fr;
    f32x4 ga[4], gx[4];
#pragma unroll
    for (int mb = 0; mb < 4; ++mb) { ga[mb] = (f32x4){0.f, 0.f, 0.f, 0.f}; gx[mb] = (f32x4){0.f, 0.f, 0.f, 0.f}; }
    const bf16* wa = gT + ((size_t)((E * 2 + 0) * 8 + wave) * 64 + 16 * nb + fr) * 64 + 8 * g;
    const bf16* wx = wa + 8 * 4096;
#pragma unroll
    for (int ks = 0; ks < 2; ++ks) {
      const bf16x8 Ba = *(const bf16x8*)(wa + 32 * ks), Bx = *(const bf16x8*)(wx + 32 * ks);
#pragma unroll
      for (int mb = 0; mb < 4; ++mb) {
        const bf16x8 A = *(const bf16x8*)(XC + (16 * mb + fr) * XCS + 64 * wave + 32 * ks + 8 * g);
        ga[mb] = __builtin_amdgcn_mfma_f32_16x16x32_bf16(A, Ba, ga[mb], 0, 0, 0);
        gx[mb] = __builtin_amdgcn_mfma_f32_16x16x32_bf16(A, Bx, gx[mb], 0, 0, 0);
      }
    }
    const float ba = p.in[6][(l * 2 + E) * 512 + ch], bx = p.in[8][(l * 2 + E) * 512 + ch], c8 = c8t[(l * 2 + E) * 512 + ch];
#pragma unroll
    for (int mb = 0; mb < 4; ++mb)
#pragma unroll
      for (int j = 0; j < 4; ++j) {
        const float r = fast_sigmoid(ga[mb][j] + ba), ii = fast_sigmoid(gx[mb][j] + bx);
        const float la = -c8 * r;
        const float a = __builtin_amdgcn_exp2f(1.4426950408889634f * la);
        const float y = 2.0f * la;
        const float poly = -y * (1.0f + y * (0.5f + y * (0.16666667f + y * (0.041666668f + y * (0.008333334f + y * 0.0013888889f)))));
        const float om = (y > -0.3f) ? poly : (1.0f - a * a);
        const float xcv = bf2f(XC[(16 * mb + 4 * g + j) * XCS + ch]);
        ga[mb][j] = a; gx[mb][j] = __builtin_amdgcn_sqrtf(om) * ii * xcv;
      }
    float Hc = 0.f, Ac = 1.f;
    if (FINAL) Hc = ((const float*)(p.ws + WS_CARRY))[((size_t)chunk * 2 + E) * 512 + ch];
#pragma unroll
    for (int mbi = 0; mbi < 4; ++mbi) {
      const int mb = (E == 0) ? mbi : 3 - mbi;
      float P = 1.f, Hl = 0.f, hl[4], pl[4];
#pragma unroll
      for (int ji = 0; ji < 4; ++ji) { const int j = (E == 0) ? ji : 3 - ji; Hl = ga[mb][j] * Hl + gx[mb][j]; P *= ga[mb][j]; hl[j] = Hl; pl[j] = P; }
      float Ag[4], Bg[4];
#pragma unroll
      for (int k = 0; k < 4; ++k) { Ag[k] = __shfl(P, fr + 16 * k); Bg[k] = __shfl(Hl, fr + 16 * k); }
      float c = Hc, cin = Hc;
#pragma unroll
      for (int ki = 0; ki < 4; ++ki) { const int k = (E == 0) ? ki : 3 - ki; if (g == k) cin = c; c = Ag[k] * c + Bg[k]; }
      Hc = c;
      if (!FINAL) Ac *= (Ag[0] * Ag[1]) * (Ag[2] * Ag[3]);
      if (FINAL) {
#pragma unroll
        for (int j = 0; j < 4; ++j) { const float h = hl[j] + pl[j] * cin; if (E == 0) hs[mb][j] = h; else hs[mb][j] += h; }
      }
    }
    if (!FINAL) { if (g == 0) { float2 v; v.x = Ac; v.y = Hc; ((float2*)(p.ws + WS_AGG))[((size_t)chunk * 2 + E) * 512 + ch] = v; } }
  }
}

template <bool FINAL>
__device__ __forceinline__ void rg_unit(const Params& p, unsigned char* lds, int l, int chunk, int tid, int lane, int wave) {
  bf16* XC = (bf16*)lds;
  bf16* YR = (bf16*)(lds + 66560);
  float* SSQ = (float*)(lds + 133120);
  float* RSTD = (float*)(lds + 133120 + 2048);
  bf16* proj = (bf16*)(p.ws + WS_PROJ);
  const int t0 = chunk * 64;
  int s0, s1; seq_bounds(t0, s0, s1);
  {
    const int c0 = (tid & 63) * 8;
    float w[4][8], bb[8];
#pragma unroll
    for (int k = 0; k < 4; ++k) { const f32x4 a = *(const f32x4*)(p.in[3] + (size_t)(l * 4 + k) * 512 + c0), b = *(const f32x4*)(p.in[3] + (size_t)(l * 4 + k) * 512 + c0 + 4);
      w[k][0] = a.x; w[k][1] = a.y; w[k][2] = a.z; w[k][3] = a.w; w[k][4] = b.x; w[k][5] = b.y; w[k][6] = b.z; w[k][7] = b.w; }
    { const f32x4 a = *(const f32x4*)(p.in[4] + (size_t)l * 512 + c0), b = *(const f32x4*)(p.in[4] + (size_t)l * 512 + c0 + 4);
      bb[0] = a.x; bb[1] = a.y; bb[2] = a.z; bb[3] = a.w; bb[4] = b.x; bb[5] = b.y; bb[6] = b.z; bb[7] = b.w; }
#pragma unroll 2
    for (int j = 0; j < 8; ++j) {
      const int tt = (tid >> 6) + 8 * j, t = t0 + tt;
      float acc[8];
#pragma unroll
      for (int i = 0; i < 8; ++i) acc[i] = bb[i];
#pragma unroll
      for (int k = 0; k < 4; ++k) { const int tk = t + k - 2;
        if (tk >= s0 && tk < s1) { const v4u raw = *(const v4u*)(proj + (size_t)tk * NPROJ + c0);
          acc[0] += w[k][0] * bflo(raw.x); acc[1] += w[k][1] * bfhi(raw.x); acc[2] += w[k][2] * bflo(raw.y); acc[3] += w[k][3] * bfhi(raw.y);
          acc[4] += w[k][4] * bflo(raw.z); acc[5] += w[k][5] * bfhi(raw.z); acc[6] += w[k][6] * bflo(raw.w); acc[7] += w[k][7] * bfhi(raw.w); } }
      v4u o; o.x = pk2(acc[0], acc[1]); o.y = pk2(acc[2], acc[3]); o.z = pk2(acc[4], acc[5]); o.w = pk2(acc[6], acc[7]);
      *(v4u*)(XC + tt * XCS + c0) = o;
      if (FINAL) *(v4u*)(YR + tt * XCS + c0) = *(const v4u*)(proj + (size_t)t * NPROJ + 512 + c0);
    }
  }
  __syncthreads();
  const int fr = lane & 15, g = lane >> 4;
  float part[4][4];
#pragma unroll
  for (int mb = 0; mb < 4; ++mb)
#pragma unroll
    for (int j = 0; j < 4; ++j) part[mb][j] = 0.f;
#pragma unroll 1
  for (int nb = 0; nb < 4; ++nb) {
    f32x4 hs[4];
    rg_dir<FINAL, 0>(p, XC, l, chunk, wave, fr, g, nb, hs);
    rg_dir<FINAL, 1>(p, XC, l, chunk, wave, fr, g, nb, hs);
    if (FINAL) {
      bf16* yrb = YR + (4 * g) * XCS + 64 * wave + 16 * nb + fr; asm volatile("" : "+v"(yrb));
#pragma unroll
      for (int mb = 0; mb < 4; ++mb)
#pragma unroll
        for (int j = 0; j < 4; ++j) { const float v = hs[mb][j] * bf2f(yrb[(16 * mb + j) * XCS]); part[mb][j] += v * v; yrb[(16 * mb + j) * XCS] = (bf16)f2bf(v); }
    }
  }
  if (FINAL) {
    float* sqb = SSQ + 32 * g + wave; asm volatile("" : "+v"(sqb));
#pragma unroll
    for (int mb = 0; mb < 4; ++mb)
#pragma unroll
      for (int j = 0; j < 4; ++j) { float s = part[mb][j]; s += __shfl_xor(s, 1); s += __shfl_xor(s, 2); s += __shfl_xor(s, 4); s += __shfl_xor(s, 8);
        if (fr == 0) sqb[(16 * mb + j) * 8] = s; }
    __syncthreads();
    if (tid < 64) { float s = 0.f;
#pragma unroll
      for (int w8 = 0; w8 < 8; ++w8) s += SSQ[tid * 8 + w8];
      RSTD[tid] = 1.0f / sqrtf(s * (1.0f / 512.0f) + 1e-6f); }
    __syncthreads();
    { const int c0 = (tid & 63) * 8;
      const f32x4 g0 = *(const f32x4*)(p.in[12] + (size_t)l * 512 + c0), g1 = *(const f32x4*)(p.in[12] + (size_t)l * 512 + c0 + 4);
#pragma unroll
      for (int j = 0; j < 8; ++j) { const int tt = (tid >> 6) + 8 * j; const float r = RSTD[tt]; const v4u raw = *(const v4u*)(YR + tt * XCS + c0);
        v4u o; o.x = pk2(bflo(raw.x) * r * g0.x, bfhi(raw.x) * r * g0.y); o.y = pk2(bflo(raw.y) * r * g0.z, bfhi(raw.y) * r * g0.w);
        o.z = pk2(bflo(raw.z) * r * g1.x, bfhi(raw.z) * r * g1.y); o.w = pk2(bflo(raw.w) * r * g1.z, bfhi(raw.w) * r * g1.w);
        *(v4u*)(proj + (size_t)(t0 + tt) * NPROJ + 512 + c0) = o; } }
  }
  __syncthreads();
}

__device__ __forceinline__ void rg_carry(const Params& p, int gw, int NGW, int lane) {
  const float2* agg = (const float2*)(p.ws + WS_AGG); float* carry = (float*)(p.ws + WS_CARRY);
  for (int it = gw; it < 18 * 2 * 8; it += NGW) {
    const int s = it / 16, e = (it >> 3) & 1, cgp = it & 7, ch = cgp * 64 + lane;
    const int c0 = (s < 16) ? 32 * s : 512 + 256 * (s - 16), nc = (s < 16) ? 32 : 256;
    float h = 0.f;
#pragma unroll 8
    for (int i = 0; i < nc; ++i) { const int c = (e == 0) ? c0 + i : c0 + nc - 1 - i; const size_t idx = ((size_t)c * 2 + e) * 512 + ch;
      const float2 ab = agg[idx]; carry[idx] = h; h = ab.x * h + ab.y; }
  }
}

constexpr int KS = 72;
__device__ __forceinline__ void attn_unit(const Params& p, unsigned char* lds, int l, int unit, int tid, int lane, int wave) {
  bf16* KL = (bf16*)lds;
  bf16* VT = (bf16*)(lds + 18432);
  const float* BIAS = (const float*)(lds + 36864);
  float* SSQ = (float*)(lds + 36864 + 8320);
  float* RSTD = SSQ + 512;
  bf16* proj = (bf16*)(p.ws + WS_PROJ);
  const int q0 = unit * 64; int s0, s1; seq_bounds(q0, s0, s1);
  const int h = wave, kvh = wave >> 2, fr = lane & 15, g = lane >> 4;
  bf16* QL = (bf16*)(lds + 49152) + wave * 64 * KS + fr * KS + 8 * g; asm volatile("" : "+v"(QL));
#pragma unroll
  for (int qb = 0; qb < 4; ++qb)
#pragma unroll
    for (int ks = 0; ks < 2; ++ks) *(v4u*)(QL + (16 * qb) * KS + 32 * ks) = *(const v4u*)(proj + (size_t)(q0 + 16 * qb + fr) * NPROJ + 1024 + 64 * h + 32 * ks + 8 * g);
  float m[4], lsum[4]; f32x4 O[4][4];
  const float sink = p.in[10][l * 8 + h];
#pragma unroll
  for (int qb = 0; qb < 4; ++qb) { m[qb] = sink; lsum[qb] = (g == 0) ? 1.f : 0.f;
#pragma unroll
    for (int db = 0; db < 4; ++db) O[qb][db] = (f32x4){0.f, 0.f, 0.f, 0.f}; }
  for (int jt = 0; jt < 5; ++jt) {
    const int kt0 = q0 - 128 + 64 * jt;
    if (kt0 < s0 || kt0 >= s1) continue;
    __syncthreads();
#pragma unroll
    for (int i = 0; i < 2; ++i) { const int id = tid + 512 * i, kv = id >> 9, key = (id & 511) >> 3, part = id & 7;
      *(v4u*)(KL + (kv * 64 + key) * KS + part * 8) = *(const v4u*)(proj + (size_t)(kt0 + key) * NPROJ + 1536 + 64 * kv + 8 * part); }
#pragma unroll
    for (int i = 0; i < 2; ++i) { const int id = tid + 512 * i, kv = id >> 9, key = id & 63, part = (id >> 6) & 7;
      const v4u raw = *(const v4u*)(proj + (size_t)(kt0 + key) * NPROJ + 1664 + 64 * kv + 8 * part);
      bf16* vt = VT + (kv * 64 + 8 * part) * KS + key;
      vt[0 * KS] = (bf16)(raw.x & 0xffffu); vt[1 * KS] = (bf16)(raw.x >> 16); vt[2 * KS] = (bf16)(raw.y & 0xffffu); vt[3 * KS] = (bf16)(raw.y >> 16);
      vt[4 * KS] = (bf16)(raw.z & 0xffffu); vt[5 * KS] = (bf16)(raw.z >> 16); vt[6 * KS] = (bf16)(raw.w & 0xffffu); vt[7 * KS] = (bf16)(raw.w >> 16); }
    __syncthreads();
#pragma unroll 1
    for (int sh = 0; sh < 2; ++sh) {
    bf16x8 Kf[2][2], Vf[4];
#pragma unroll
    for (int kb = 0; kb < 2; ++kb)
#pragma unroll
      for (int ks = 0; ks < 2; ++ks) Kf[kb][ks] = *(const bf16x8*)(KL + (kvh * 64 + 32 * sh + 16 * kb + fr) * KS + 32 * ks + 8 * g);
#pragma unroll
    for (int db = 0; db < 4; ++db) { const bf16* vp = VT + (kvh * 64 + 16 * db + fr) * KS + 32 * sh + 4 * g;
      const v2u lo = *(const v2u*)vp, hi = *(const v2u*)(vp + 16); v4u t; t.x = lo.x; t.y = lo.y; t.z = hi.x; t.w = hi.y; Vf[db] = __builtin_bit_cast(bf16x8, t); }
#pragma unroll
    for (int qb = 0; qb < 4; ++qb) {
      f32x4 S[2];
      const bf16x8 Q0 = *(const bf16x8*)(QL + (16 * qb) * KS), Q1 = *(const bf16x8*)(QL + (16 * qb) * KS + 32);
#pragma unroll
      for (int kb = 0; kb < 2; ++kb) { S[kb] = (f32x4){0.f, 0.f, 0.f, 0.f};
        S[kb] = __builtin_amdgcn_mfma_f32_16x16x32_bf16(Kf[kb][0], Q0, S[kb], 0, 0, 0);
        S[kb] = __builtin_amdgcn_mfma_f32_16x16x32_bf16(Kf[kb][1], Q1, S[kb], 0, 0, 0); }
      const int qpos = q0 + 16 * qb + fr;
      float mx = m[qb];
#pragma unroll
      for (int kb = 0; kb < 2; ++kb)
#pragma unroll
        for (int j = 0; j < 4; ++j) { const int rel = (kt0 + 32 * sh + 16 * kb + 4 * g + j) - qpos; int idx = rel + 128; idx = idx < 0 ? 0 : (idx > 256 ? 256 : idx);
          float s = S[kb][j] * 0.125f + BIAS[h * 260 + idx]; if (rel < -128 || rel > 128) s = -1e30f; S[kb][j] = s; mx = fmaxf(mx, s); }
      mx = fmaxf(mx, __shfl_xor(mx, 16)); mx = fmaxf(mx, __shfl_xor(mx, 32));
      const float alpha = __builtin_amdgcn_exp2f((m[qb] - mx) * 1.4426950408889634f); m[qb] = mx;
      float ps = 0.f;
#pragma unroll
      for (int kb = 0; kb < 2; ++kb)
#pragma unroll
        for (int j = 0; j < 4; ++j) { const float pv = __builtin_amdgcn_exp2f((S[kb][j] - mx) * 1.4426950408889634f); ps += pv; S[kb][j] = pv; }
      lsum[qb] = lsum[qb] * alpha + ps;
#pragma unroll
      for (int db = 0; db < 4; ++db) O[qb][db] = O[qb][db] * alpha;
      { v4u t; t.x = pk2(S[0][0], S[0][1]); t.y = pk2(S[0][2], S[0][3]); t.z = pk2(S[1][0], S[1][1]); t.w = pk2(S[1][2], S[1][3]);
        const bf16x8 P = __builtin_bit_cast(bf16x8, t);
#pragma unroll
        for (int db = 0; db < 4; ++db) O[qb][db] = __builtin_amdgcn_mfma_f32_16x16x32_bf16(Vf[db], P, O[qb][db], 0, 0, 0); }
    }
    }
  }
#pragma unroll
  for (int qb = 0; qb < 4; ++qb) { float L = lsum[qb]; L += __shfl_xor(L, 16); L += __shfl_xor(L, 32); const float inv = 1.0f / L; float s = 0.f;
#pragma unroll
    for (int db = 0; db < 4; ++db) { O[qb][db] = O[qb][db] * inv; s += (O[qb][db][0] * O[qb][db][0] + O[qb][db][1] * O[qb][db][1]) + (O[qb][db][2] * O[qb][db][2] + O[qb][db][3] * O[qb][db][3]); }
    s += __shfl_xor(s, 16); s += __shfl_xor(s, 32);
    if (g == 0) SSQ[(16 * qb + fr) * 8 + wave] = s; }
  __syncthreads();
  if (tid < 64) { float s = 0.f;
#pragma unroll
    for (int w8 = 0; w8 < 8; ++w8) s += SSQ[tid * 8 + w8];
    RSTD[tid] = 1.0f / sqrtf(s * (1.0f / 512.0f) + 1e-6f); }
  __syncthreads();
#pragma unroll
  for (int qb = 0; qb < 4; ++qb) { const float r = RSTD[16 * qb + fr];
#pragma unroll
    for (int db = 0; db < 4; ++db) { const int ch = 64 * h + 16 * db + 4 * g; const f32x4 gv = *(const f32x4*)(p.in[13] + (size_t)l * 512 + ch);
      const f32x4 o = O[qb][db] * r * gv; v2u w; w.x = pk2(o[0], o[1]); w.y = pk2(o[2], o[3]);
      *(v2u*)(proj + (size_t)(q0 + 16 * qb + fr) * NPROJ + 1024 + ch) = w; } }
}

__device__ __forceinline__ void attn_bias_table(const Params& p, unsigned char* lds, int tid) {
  float* BIAS = (float*)(lds + 36864);
  for (int idx = tid; idx < 8 * 257; idx += 512) { const int hh = idx / 257, r = idx % 257 - 128; const int n = r < 0 ? -r : r; int b;
    if (n < 8) b = n; else { const int k = 31 - __clz((n * n) >> 6); b = 8 + k; if (b > 15) b = 15; }
    if (r > 0) b += 16;
    BIAS[hh * 260 + r + 128] = p.in[11][b * 8 + hh]; }
}

__device__ __forceinline__ void ffn_gate_rows(const Params& p, int l, int r0, int nrows, int gtid, int nthreads) {
  const bf16* gu = (const bf16*)(p.ws + WS_GU); bf16* H = (bf16*)(p.ws + WS_H);
  const float* cw = p.in[18] + (size_t)l * 3 * DFF; const float* cb = p.in[19] + (size_t)l * DFF;
  const int total = nrows * (DFF / 8);
  for (int idx = gtid; idx < total; idx += nthreads) {
    const int rr = idx / (DFF / 8), c0 = (idx % (DFF / 8)) * 8, row = r0 + rr;
    int s0, s1; seq_bounds(row, s0, s1);
    const bf16* gp = gu + (size_t)rr * NGU + c0;
    const v4u gm = *(const v4u*)gp, uu = *(const v4u*)(gp + DFF);
    v4u gl = (v4u){0u, 0u, 0u, 0u}, gr = (v4u){0u, 0u, 0u, 0u};
    if (row > s0) gl = *(const v4u*)(gp - NGU);
    if (row + 1 < s1) gr = *(const v4u*)(gp + NGU);
    float o[8];
    const unsigned gmw[4] = {gm.x, gm.y, gm.z, gm.w}, glw[4] = {gl.x, gl.y, gl.z, gl.w}, grw[4] = {gr.x, gr.y, gr.z, gr.w}, uw[4] = {uu.x, uu.y, uu.z, uu.w};
#pragma unroll
    for (int q = 0; q < 4; ++q) {
#pragma unroll
      for (int hlf = 0; hlf < 2; ++hlf) { const int c = c0 + 2 * q + hlf;
        const float a = hlf ? bfhi(glw[q]) : bflo(glw[q]), b = hlf ? bfhi(gmw[q]) : bflo(gmw[q]), d = hlf ? bfhi(grw[q]) : bflo(grw[q]), uv = hlf ? bfhi(uw[q]) : bflo(uw[q]);
        const float cv = cb[c] + cw[c] * a + cw[DFF + c] * b + cw[2 * DFF + c] * d;
        o[2 * q + hlf] = gelu_tanh(cv) * uv; } }
    v4u w; w.x = pk2(o[0], o[1]); w.y = pk2(o[2], o[3]); w.z = pk2(o[4], o[5]); w.w = pk2(o[6], o[7]);
    *(v4u*)(H + (size_t)row * DFF + c0) = w;
  }
}

__global__ void __launch_bounds__(512, 2) fwd_kernel(Params p) {
  cg::grid_group grid = cg::this_grid();
  extern __shared__ __attribute__((aligned(16))) unsigned char lds[];
  const int G = gridDim.x, bx = blockIdx.x, NGW = G * 8;
#define TIDS int tid = threadIdx.x; asm volatile("" : "+v"(tid)); const int lane = tid & 63, wave = __builtin_amdgcn_readfirstlane(tid >> 6), gw = bx * 8 + wave; (void)lane; (void)gw;
  float* X = p.out;
  bf16* XB = (bf16*)(p.ws + WS_XB);
  bf16* proj = (bf16*)(p.ws + WS_PROJ);
  bf16* GU = (bf16*)(p.ws + WS_GU);
  bf16* H = (bf16*)(p.ws + WS_H);
  PG8_LAS unsigned char* glds = (PG8_LAS unsigned char*)lds;

#ifndef ONLY
#define ONLY 0
#endif
#define PH(k) if (ONLY == 0 || ONLY == (k))
  PH(1) { TIDS p0_prologue(p, lds, gw, NGW, lane, wave); }
  grid.sync();

  for (int l = 0; l < DEPTH; ++l) {
    const bf16* wl = (const bf16*)(p.ws + WS_W) + (size_t)l * W_LAYER_E;
    const bf16* w_in_t = wl; const bf16* w_out_t = wl + W_IN_E; const bf16* w_fi_t = w_out_t + W_OUT_E; const bf16* w_fo_t = w_fi_t + W_FI_E;
    PH(2) { pg8::Gemm g{XB, w_in_t, NTOK, NPROJ, DM, DM, 256}; pg8::StaticOrder S; S.init(NTOK, NPROJ, G, bx);
      pg8::EpiProj E{proj, NPROJ, 2, 4};
      pg8::gemm_phase<pg8::EpiProj, pg8::StaticOrder, true, true>(glds, g, S, E); }
    grid.sync();
    PH(3) { TIDS for (int u = bx; u < 1024; u += G) rg_unit<false>(p, lds, l, u, tid, lane, wave); }
    PH(4) { TIDS attn_bias_table(p, lds, tid);
    __syncthreads();
    for (int u = bx; u < 1024; u += G) attn_unit(p, lds, l, u, tid, lane, wave); }
    grid.sync();
    PH(5) { TIDS rg_carry(p, gw, NGW, lane); }
    grid.sync();
    PH(6) { TIDS for (int u = bx; u < 1024; u += G) rg_unit<true>(p, lds, l, u, tid, lane, wave); }
    grid.sync();
    PH(7) { pg8::Gemm g{proj + 512, w_out_t, NTOK, DM, DM, NPROJ, 256}; pg8::StaticOrder S; S.init(NTOK, DM, G, bx);
      pg8::EpiRes E{l == 0 ? p.in[0] : X, l == 0 ? p.in[1] - (size_t)NPROMPT * DM : X, X, ALPHA};
      pg8::gemm_phase<pg8::EpiRes, pg8::StaticOrder, true, true>(glds, g, S, E); }
    grid.sync();
    PH(8) { TIDS ln_rows(X, XB, p.in[15] + (size_t)l * DM, p.in[16] + (size_t)l * DM, gw, NGW, lane); }
    grid.sync();
    PH(9) { pg8::Gemm g{XB - DM, w_fi_t, NTOK, NGU, DM, DM, 254}; pg8::StaticOrder S; S.init(NTOK, NGU, G, bx); S.nM = 259; S.nwg = 259 * S.nN;
      pg8::EpiFfn E{H, p.in[18] + (size_t)l * 3 * DFF, p.in[19] + (size_t)l * DFF, (PG8_LAS float*)(glds + 131072)};
      pg8::gemm_phase<pg8::EpiFfn, pg8::StaticOrder, true, true>(glds, g, S, E); }
    grid.sync();
    PH(11) { pg8::Gemm g{H, w_fo_t, NTOK, DM, DFF, DFF, 256}; pg8::StaticOrder S; S.init(NTOK, DM, G, bx);
      pg8::EpiRes E{X, X, X, ALPHA};
      pg8::gemm_phase<pg8::EpiRes, pg8::StaticOrder, true, true>(glds, g, S, E); }
    grid.sync();
    PH(12) { TIDS ln_rows(X, XB, p.in[21] + (size_t)l * DM, p.in[22] + (size_t)l * DM, gw, NGW, lane); }
    grid.sync();
  }
}

extern "C" void kernel_launch(void* const* d_in, const int* in_sizes, int n_in, void* d_out, int out_size, void* d_ws, size_t ws_size, hipStream_t stream) {
  static int grid_blocks = 0;
  if (!grid_blocks) {
    int dev = 0, cus = 0, per_cu = 0;
    (void)hipGetDevice(&dev);
    (void)hipDeviceGetAttribute(&cus, hipDeviceAttributeMultiprocessorCount, dev);
    (void)hipFuncSetAttribute((const void*)fwd_kernel, hipFuncAttributeMaxDynamicSharedMemorySize, LDS_BYTES);
    (void)hipOccupancyMaxActiveBlocksPerMultiprocessor(&per_cu, fwd_kernel, 512, LDS_BYTES);
    if (per_cu < 1) per_cu = 1;
    grid_blocks = cus * per_cu;
    if (grid_blocks > 256) grid_blocks = 256;
  }
  Params p{};
  for (int i = 0; i < 23; ++i) p.in[i] = (const float*)d_in[i];
  p.out = (float*)d_out; p.ws = (unsigned char*)d_ws;
  void* args[] = {&p};
  hipError_t e = hipLaunchCooperativeKernel((void*)fwd_kernel, dim3(grid_blocks), dim3(512), args, LDS_BYTES, stream);
  if (e != hipSuccess) fprintf(stderr, "cooperative launch failed: %s (grid %d)\n", hipGetErrorString(e), grid_blocks);
}
```
